# Optimizing an MI355X kernel written in HIP

```python
import jax, jax.numpy as jnp
from jax import lax
import numpy as np

D_MODEL = 1024
BATCH = 8
SEQ = 8192
DEPTH = 2

CHUNK = 64
D_MIX = D_MODEL
EPS = 1e-6
NEG = -1e30

ATT_HEAD_DIM = 64
D_ATT = D_MIX // 4
ATT_HEADS = D_ATT // ATT_HEAD_DIM
ATT_LEFT_CHUNKS = 8
ATT_BAND = (ATT_LEFT_CHUNKS + 1) * CHUNK
MAX_REL = 128
N_REL = 2 * MAX_REL + 1

D_ML = D_MIX // 2
ML_HEADS = 4
ML_HEAD_DIM = D_ML // ML_HEADS
ML_CONV = 4

D_CONV = D_MIX - D_ATT - D_ML
CONV_WIDTH = 31

IN_SIZES = (D_ATT, D_ATT, D_ATT, D_ATT,
            D_ML, D_ML, D_ML, D_ML, D_ML,
            ML_HEADS, ML_HEADS,
            D_CONV, D_CONV, D_CONV)
D_IN = 4 * D_ATT + 5 * D_ML + 2 * ML_HEADS + 3 * D_CONV

kernel_name = "hybrid_chunk_attn_mlstm_conformer_conv"


def split_columns(h):
    parts = []
    off = 0
    for s in IN_SIZES:
        parts.append(h[..., off:off + s])
        off += s
    return parts


def rms_norm(x, g):
    xf = x.astype(jnp.float32)
    y = xf * lax.rsqrt(jnp.mean(xf * xf, axis=-1, keepdims=True) + EPS)
    return (y * g.astype(jnp.float32)).astype(x.dtype)


def layer_norm(x, g, b):
    xf = x.astype(jnp.float32)
    mu = jnp.mean(xf, axis=-1, keepdims=True)
    xc = xf - mu
    y = xc * lax.rsqrt(jnp.mean(xc * xc, axis=-1, keepdims=True) + EPS)
    return (y * g.astype(jnp.float32) + b.astype(jnp.float32)).astype(x.dtype)


def causal_depthwise_conv(x, w, b):
    width, ch = w.shape
    xp = jnp.pad(x, ((0, 0), (width - 1, 0), (0, 0)))
    out = lax.conv_general_dilated(
        xp, w[:, None, :].astype(x.dtype), window_strides=(1,), padding='VALID',
        dimension_numbers=('NWC', 'WIO', 'NWC'), feature_group_count=ch)
    return out + b.astype(x.dtype)


def chunk_band_attention(q, k, v, q_g, k_g, rel_bias):
    B, S, H, Dh = q.shape
    n_chunks = S // CHUNK
    pad = ATT_LEFT_CHUNKS * CHUNK
    q = rms_norm(q, q_g)
    k = rms_norm(k, k_g)
    kp = jnp.pad(k, ((0, 0), (pad, 0), (0, 0), (0, 0)))
    vp = jnp.pad(v, ((0, 0), (pad, 0), (0, 0), (0, 0)))
    rel = jnp.arange(CHUNK)[:, None] - jnp.arange(ATT_BAND)[None, :] + pad
    rel_idx = jnp.clip(rel, -MAX_REL, MAX_REL) + MAX_REL
    bias = rel_bias[:, rel_idx].astype(jnp.float32)
    scale = Dh ** -0.5
    qc = q.reshape(B, n_chunks, CHUNK, H, Dh).transpose(1, 0, 3, 2, 4)

    def one_chunk(args):
        c, qb = args
        start = c * CHUNK
        kb = lax.dynamic_slice_in_dim(kp, start, ATT_BAND, axis=1)
        vb = lax.dynamic_slice_in_dim(vp, start, ATT_BAND, axis=1)
        s = jnp.einsum('bhqd,bkhd->bhqk', qb, kb,
                       preferred_element_type=jnp.float32) * scale + bias
        key_pos = start - pad + jnp.arange(ATT_BAND)
        s = jnp.where(key_pos[None, None, None, :] >= 0, s, NEG)
        p = jax.nn.softmax(s, axis=-1).astype(vb.dtype)
        return jnp.einsum('bhqk,bkhd->bqhd', p, vb)

    out = lax.map(one_chunk, (jnp.arange(n_chunks), qc))
    return out.transpose(1, 0, 2, 3, 4).reshape(B, S, H * Dh)


def mlstm_chunkwise(q, k, v, i_pre, f_pre):
    B, S, H, D = q.shape
    n_chunks = S // CHUNK
    f32 = jnp.float32

    def chunks4(a):
        return a.astype(f32).reshape(B, n_chunks, CHUNK, H, D).transpose(1, 0, 3, 2, 4)

    def chunks3(a):
        return a.astype(f32).reshape(B, n_chunks, CHUNK, H).transpose(1, 0, 3, 2)

    qc = chunks4(q)
    kc = chunks4(k) * (D ** -0.5)
    vc = chunks4(v)
    ic = chunks3(i_pre)
    lfc = chunks3(jax.nn.log_sigmoid(f_pre.astype(f32)))
    causal = jnp.tril(jnp.ones((CHUNK, CHUNK), dtype=bool))

    def step(carry, xs):
        C, n, m = carry
        qb, kb, vb, ib, lfb = xs
        b = jnp.cumsum(lfb, axis=-1)
        log_d = b[..., :, None] - b[..., None, :] + ib[..., None, :]
        log_d = jnp.where(causal, log_d, NEG)
        inter = b + m[..., None]
        m_t = jnp.maximum(jnp.max(log_d, axis=-1), inter)
        d_mat = jnp.exp(log_d - m_t[..., None])
        inter_w = jnp.exp(inter - m_t)
        s = jnp.einsum('bhtd,bhsd->bhts', qb, kb) * d_mat
        num = (jnp.einsum('bhts,bhsd->bhtd', s, vb)
               + inter_w[..., None] * jnp.einsum('bhvk,bhtk->bhtv', C, qb))
        den = jnp.sum(s, axis=-1) + inter_w * jnp.einsum('bhk,bhtk->bht', n, qb)
        h = num / jnp.maximum(jnp.abs(den), jnp.exp(-m_t))[..., None]
        b_last = b[..., -1]
        w_log = b_last[..., None] - b + ib
        m_new = jnp.maximum(b_last + m, jnp.max(w_log, axis=-1))
        decay = jnp.exp(b_last + m - m_new)
        w = jnp.exp(w_log - m_new[..., None])
        C_new = decay[..., None, None] * C + jnp.einsum('bhs,bhsv,bhsk->bhvk', w, vb, kb)
        n_new = decay[..., None] * n + jnp.einsum('bhs,bhsk->bhk', w, kb)
        return (C_new, n_new, m_new), h

    init = (jnp.zeros((B, H, D, D), f32), jnp.zeros((B, H, D), f32), jnp.zeros((B, H), f32))
    _, hs = lax.scan(step, init, (qc, kc, vc, ic, lfc))
    return hs.transpose(1, 0, 3, 2, 4).reshape(B, S, H, D)


def setup_inputs(seed: int = 0) -> dict:
    key = jax.random.key(seed)
    ks = jax.random.split(key, 17)
    f32 = jnp.float32
    nrm = lambda k, shape: jax.random.normal(k, shape, f32)
    return {
        "x": nrm(ks[0], (BATCH, SEQ, D_MODEL)),
        "norm_g": 1.0 + 0.02 * nrm(ks[1], (DEPTH, D_MODEL)),
        "w_in": nrm(ks[2], (DEPTH, D_MODEL, D_IN)) * D_MODEL ** -0.5,
        "att_q_g": 1.0 + 0.02 * nrm(ks[3], (DEPTH, ATT_HEAD_DIM)),
        "att_k_g": 1.0 + 0.02 * nrm(ks[4], (DEPTH, ATT_HEAD_DIM)),
        "att_rel_bias": 0.1 * nrm(ks[5], (DEPTH, ATT_HEADS, N_REL)),
        "ml_qk_conv_w": nrm(ks[6], (DEPTH, ML_CONV, 2 * D_ML)) * ML_CONV ** -0.5,
        "ml_qk_conv_b": 0.02 * nrm(ks[7], (DEPTH, 2 * D_ML)),
        "ml_b_i": 0.1 * nrm(ks[8], (DEPTH, ML_HEADS)),
        "ml_b_f": jnp.linspace(3.0, 6.0, ML_HEADS, dtype=f32)[None, :]
                  + 0.1 * nrm(ks[9], (DEPTH, ML_HEADS)),
        "ml_out_g": 1.0 + 0.02 * nrm(ks[10], (DEPTH, D_ML)),
        "cv_dw_w": nrm(ks[11], (DEPTH, CONV_WIDTH, D_CONV)) * CONV_WIDTH ** -0.5,
        "cv_dw_b": 0.02 * nrm(ks[12], (DEPTH, D_CONV)),
        "cv_ln_g": 1.0 + 0.02 * nrm(ks[13], (DEPTH, D_CONV)),
        "cv_ln_b": 0.02 * nrm(ks[14], (DEPTH, D_CONV)),
        "w_out": nrm(ks[15], (DEPTH, D_MIX, D_MODEL)) * D_MIX ** -0.5,
    }


def reference(x, norm_g, w_in, att_q_g, att_k_g, att_rel_bias, ml_qk_conv_w, ml_qk_conv_b,
              ml_b_i, ml_b_f, ml_out_g, cv_dw_w, cv_dw_b, cv_ln_g, cv_ln_b, w_out):
    B, S, _ = x.shape
    for l in range(DEPTH):
        h = rms_norm(x, norm_g[l])
        proj = jnp.einsum('bsd,de->bse', h, w_in[l])
        (a_q, a_k, a_v, a_z, m_q, m_k, m_v, m_o, m_z, m_i, m_f,
         c_a, c_b, c_z) = split_columns(proj)

        att = chunk_band_attention(
            a_q.reshape(B, S, ATT_HEADS, ATT_HEAD_DIM),
            a_k.reshape(B, S, ATT_HEADS, ATT_HEAD_DIM),
            a_v.reshape(B, S, ATT_HEADS, ATT_HEAD_DIM),
            att_q_g[l], att_k_g[l], att_rel_bias[l])
        att = att * jax.nn.silu(a_z)

        qk = jax.nn.silu(causal_depthwise_conv(jnp.concatenate([m_q, m_k], axis=-1),
                                               ml_qk_conv_w[l], ml_qk_conv_b[l]))
        m_q, m_k = qk[..., :D_ML], qk[..., D_ML:]
        i_pre = m_i.astype(jnp.float32) + ml_b_i[l].astype(jnp.float32)
        f_pre = m_f.astype(jnp.float32) + ml_b_f[l].astype(jnp.float32)
        hm = mlstm_chunkwise(
            m_q.reshape(B, S, ML_HEADS, ML_HEAD_DIM),
            m_k.reshape(B, S, ML_HEADS, ML_HEAD_DIM),
            m_v.reshape(B, S, ML_HEADS, ML_HEAD_DIM), i_pre, f_pre)
        hm = jax.nn.sigmoid(m_o.astype(jnp.float32)).reshape(B, S, ML_HEADS, ML_HEAD_DIM) * hm
        hm = rms_norm(hm, ml_out_g[l].reshape(ML_HEADS, ML_HEAD_DIM).astype(jnp.float32))
        ml = hm.reshape(B, S, D_ML).astype(x.dtype) * jax.nn.silu(m_z)

        u = c_a * jax.nn.sigmoid(c_b)
        u = causal_depthwise_conv(u, cv_dw_w[l], cv_dw_b[l])
        u = jax.nn.silu(layer_norm(u, cv_ln_g[l], cv_ln_b[l]))
        cv = u * jax.nn.silu(c_z)

        mixed = jnp.concatenate([att.astype(x.dtype), ml, cv.astype(x.dtype)], axis=-1)
        x = x + jnp.einsum('bse,ed->bsd', mixed, w_out[l])
    return x
```

```cpp
#include <hip/hip_runtime.h>
#include <cstdio>
#include <cstdint>
#ifndef MK_N_LAUNCHES
#define MK_N_LAUNCHES 1
#endif
namespace pg8 {
#define PG8_LAS __attribute__((address_space(3)))
typedef unsigned short bf16_t;
typedef short bf16x8 __attribute__((ext_vector_type(8)));
typedef float f32x4 __attribute__((ext_vector_type(4)));
typedef unsigned u32x4 __attribute__((ext_vector_type(4)));
constexpr int BM = 256, BK = 64, HALF = 128, HTB = HALF * BK * 2  , STAGE_BYTES = 8 * HTB, NXCD = 8, WGM = 8;

__host__ __device__ __forceinline__ int lds_byte(int r, int c) { const int st = (r >> 4) * 2 + (c >> 5), rr = r & 15, cc = c & 31, ob = rr * 64 + cc * 2; return st * 1024 + (ob ^ (((ob >> 9) & 1) << 5)); }
__host__ __device__ __forceinline__ void stage_rc(int b, int& R, int& C) { const int st = b / 1024, sb = b % 1024, swz = sb ^ (((sb >> 9) & 1) << 5); R = (st >> 1) * 16 + swz / 64; C = (st & 1) * 32 + (swz % 64) / 2; }
__host__ __device__ __forceinline__ int perm32(int rho) { const int n = rho >> 4, i = rho & 15; return 8 * (i >> 2) + 4 * n + (i & 3); }

struct Unit { int pm, pn; };
struct Gemm { const bf16_t* A; const bf16_t* Bt; int M, N, K; };

struct StaticOrder {
    int nM, nN, nwg, G, c;
    __host__ __device__ void init(int M, int N, int G_, int c_) { nM = M / BM; nN = N / BM; nwg = nM * nN; G = G_; c = c_; }
    __host__ __device__ bool next(int i, Unit& u) const {
        const long L = (long)i * G + c; if (L >= nwg) return false;
        int wgid = (int)L; { const int q = nwg / NXCD, r = nwg % NXCD, xcd = wgid % NXCD, off = wgid / NXCD; wgid = (xcd < r ? xcd * (q + 1) : r * (q + 1) + (xcd - r) * q) + off; }
        const int nig = WGM * nN, gid = wgid / nig, fm = gid * WGM, gsz = (nM - fm) < WGM ? (nM - fm) : WGM;
        u.pm = fm + ((wgid % nig) % gsz); u.pn = (wgid % nig) / gsz; return true;
    }
    __device__ __forceinline__ void a_ready(const Unit&) const {}
    __device__ __forceinline__ void done(const Unit&) const {}
};

__device__ __forceinline__ unsigned cvt_pk_bf16(float lo, float hi) { unsigned r; asm volatile("v_cvt_pk_bf16_f32 %0, %1, %2" : "=v"(r) : "v"(lo), "v"(hi)); return r; }
__device__ __forceinline__ float sigmoid_f(float x) { return __builtin_amdgcn_rcpf(1.0f + __builtin_amdgcn_exp2f(-1.4426950408889634f * x)); }
__device__ __forceinline__ f32x4 sigmoid4(f32x4 v) { return (f32x4){sigmoid_f(v[0]), sigmoid_f(v[1]), sigmoid_f(v[2]), sigmoid_f(v[3])}; }

struct EpiIn {
    static constexpr bool PERM = true, AFTER_DRAIN = false;
    unsigned char* ws; const float* ss; const float* qg; const float* kg; float qscale;
    __device__ __forceinline__ void operator()(const f32x4 (&acc)[2][2][4][2], const Unit& u, int wr, int wc, int fr, int fq) const {
        const int j = u.pn;
        const int row0 = u.pm * BM + wr * 64 + fr;
        float rs[2][4];
#pragma unroll
        for (int ai = 0; ai < 2; ++ai)
#pragma unroll
            for (int m = 0; m < 4; ++m) rs[ai][m] = 1.0f / sqrtf(ss[row0 + ai * HALF + m * 16] * (1.0f / 1024.0f) + 1e-6f);
        int type, ld, coff; size_t boff;
        if (j < 4) { ld = 256; coff = 0; boff = (size_t)(256 + 32 * j) << 20; type = (j == 0) ? 3 : (j == 1) ? 4 : (j == 2) ? 0 : 1; }
        else if (j < 14) { const int t = (j - 4) >> 1; ld = 512; coff = 256 * ((j - 4) & 1); boff = (size_t)(384 + 64 * t) << 20; type = (t == 3) ? 2 : (t == 4) ? 1 : 0; }
        else if (j < 16) { ld = 256; coff = 128 * (j - 14); boff = (size_t)704 << 20; type = 5; }
        else { ld = 256; coff = 0; boff = (size_t)736 << 20; type = 1; }
        bf16_t* base = (bf16_t*)(ws + boff);
        if (type == 5) {
#pragma unroll
            for (int ai = 0; ai < 2; ++ai)
#pragma unroll
                for (int m = 0; m < 4; ++m) { const float s = rs[ai][m]; bf16_t* p = base + (size_t)(row0 + ai * HALF + m * 16) * ld + coff + 32 * wc + 8 * fq;
                    const f32x4 a0 = acc[ai][0][m][0] * s, a1 = acc[ai][0][m][1] * s, b0 = sigmoid4(acc[ai][1][m][0] * s), b1 = sigmoid4(acc[ai][1][m][1] * s);
                    const f32x4 v0 = a0 * b0, v1 = a1 * b1;
                    u32x4 w; w.x = cvt_pk_bf16(v0[0], v0[1]); w.y = cvt_pk_bf16(v0[2], v0[3]); w.z = cvt_pk_bf16(v1[0], v1[1]); w.w = cvt_pk_bf16(v1[2], v1[3]);
                    *(u32x4*)p = w; }
        } else if (type == 3 || type == 4) {
            const float* gp = (type == 3) ? qg : kg; const float sc = (type == 3) ? qscale : 1.0f;
            f32x4 gv[2][2];
#pragma unroll
            for (int bj = 0; bj < 2; ++bj)
#pragma unroll
                for (int n = 0; n < 2; ++n) gv[bj][n] = *(const f32x4*)(gp + 32 * bj + 8 * fq + 4 * n) * sc;
#pragma unroll
            for (int ai = 0; ai < 2; ++ai)
#pragma unroll
                for (int m = 0; m < 4; ++m) { const float s = rs[ai][m]; bf16_t* p = base + (size_t)(row0 + ai * HALF + m * 16) * ld + coff + 64 * wc + 8 * fq;
                    f32x4 v[2][2]; float q = 0.f;
#pragma unroll
                    for (int bj = 0; bj < 2; ++bj)
#pragma unroll
                        for (int n = 0; n < 2; ++n) { v[bj][n] = acc[ai][bj][m][n] * s; const f32x4 x = v[bj][n]; q += (x[0] * x[0] + x[1] * x[1]) + (x[2] * x[2] + x[3] * x[3]); }
                    q += __shfl_xor(q, 16); q += __shfl_xor(q, 32);
                    const float hr = 1.0f / sqrtf(q * (1.0f / 64.0f) + 1e-6f);
#pragma unroll
                    for (int bj = 0; bj < 2; ++bj) { const f32x4 v0 = v[bj][0] * hr * gv[bj][0], v1 = v[bj][1] * hr * gv[bj][1];
                        u32x4 w; w.x = cvt_pk_bf16(v0[0], v0[1]); w.y = cvt_pk_bf16(v0[2], v0[3]); w.z = cvt_pk_bf16(v1[0], v1[1]); w.w = cvt_pk_bf16(v1[2], v1[3]);
                        *(u32x4*)(p + 32 * bj) = w; } }
        } else {
#pragma unroll
            for (int ai = 0; ai < 2; ++ai)
#pragma unroll
                for (int m = 0; m < 4; ++m) { const float s = rs[ai][m]; bf16_t* p = base + (size_t)(row0 + ai * HALF + m * 16) * ld + coff + 64 * wc + 8 * fq;
#pragma unroll
                    for (int bj = 0; bj < 2; ++bj) { f32x4 v0 = acc[ai][bj][m][0] * s, v1 = acc[ai][bj][m][1] * s;
                        if (type == 1) { v0 = v0 * sigmoid4(v0); v1 = v1 * sigmoid4(v1); }
                        else if (type == 2) { v0 = sigmoid4(v0); v1 = sigmoid4(v1); }
                        u32x4 w; w.x = cvt_pk_bf16(v0[0], v0[1]); w.y = cvt_pk_bf16(v0[2], v0[3]); w.z = cvt_pk_bf16(v1[0], v1[1]); w.w = cvt_pk_bf16(v1[2], v1[3]);
                        *(u32x4*)(p + 32 * bj) = w; } }
        }
    }
};

struct EpiOut {
    static constexpr bool PERM = false, AFTER_DRAIN = false;
    const float* base; float* out; bf16_t* xn; float* ssq;
    __device__ __forceinline__ void operator()(const f32x4 (&acc)[2][2][4][2], const Unit& u, int wr, int wc, int fr, int fq) const {
        typedef unsigned u32x2v __attribute__((ext_vector_type(2)));
        const int row0 = u.pm * BM + wr * 64 + fr, col0 = u.pn * BM + wc * 32 + 4 * fq;
#pragma unroll
        for (int ai = 0; ai < 2; ++ai)
#pragma unroll
            for (int m = 0; m < 4; ++m) { const int r = row0 + ai * HALF + m * 16; const size_t off = (size_t)r * 1024 + col0; float q = 0.f;
#pragma unroll
                for (int bj = 0; bj < 2; ++bj)
#pragma unroll
                    for (int n = 0; n < 2; ++n) { const size_t o2 = off + bj * HALF + n * 16; const f32x4 o = *(const f32x4*)(base + o2) + acc[ai][bj][m][n];
                        *(f32x4*)(out + o2) = o;
                        if (xn) { u32x2v w; w.x = cvt_pk_bf16(o[0], o[1]); w.y = cvt_pk_bf16(o[2], o[3]); *(u32x2v*)(xn + o2) = w; q += (o[0] * o[0] + o[1] * o[1]) + (o[2] * o[2] + o[3] * o[3]); } }
                if (xn) { q += __shfl_xor(q, 16); q += __shfl_xor(q, 32); if (fq == 0) atomicAdd(ssq + r, q); } }
    }
};

template <class Epi, class Sched, bool ALIGN_EPI = false, bool SP2 = false>
__device__ __forceinline__ void gemm_phase(PG8_LAS unsigned char* lds, const Gemm g, const Sched& S, const Epi& E) {
    int tid_ = threadIdx.x; asm volatile("" : "+v"(tid_));
    const int tid = tid_, wid = __builtin_amdgcn_readfirstlane(tid >> 6), lane = tid & 63, wr = wid >> 2, wc = wid & 3, fr = lane & 15, fq = lane >> 4;
    const int K = g.K, nt = K / BK;
    unsigned voffA[2], voffB[2];
#pragma unroll
    for (int i = 0; i < 2; ++i) { int R, C; stage_rc(tid * 16 + i * 8192, R, C); const int Rb = Epi::PERM ? ((R & ~31) + perm32(R & 31)) : R;
        voffA[i] = (unsigned)(R * K + C) * 2u; voffB[i] = (unsigned)(Rb * K + C) * 2u; }
    const size_t kstep = (size_t)(BK * 2);
    const size_t hstep = (size_t)HALF * K * 2;
    const size_t tstep = 2 * hstep;
    const unsigned ldsw = (unsigned)wid * 1024u;
    const int aoff = lds_byte(wr * 64 + fr, fq * 8), boff = lds_byte(wc * 32 + fr, fq * 8);
#define PG8_SA(b, h) (((b) * 2 + (h)) * HTB)
#define PG8_SB(b, h) ((4 + (b) * 2 + (h)) * HTB)
#define PG8_STAGE(bufoff, gbase, voff) do { _Pragma("unroll") for (int _i = 0; _i < 2; ++_i) \
        __builtin_amdgcn_global_load_lds((const unsigned*)((const char*)(gbase) + (voff)[_i]), (PG8_LAS unsigned*)(lds + (bufoff) + ldsw + _i * 8192), 16, 0, 0); } while (0)
#define PG8_LDA(dst, b, h) do { _Pragma("unroll") for (int m = 0; m < 4; ++m) _Pragma("unroll") for (int k = 0; k < 2; ++k) dst[m][k] = *(const PG8_LAS bf16x8*)(lds + PG8_SA(b, h) + aoff + m * 2048 + k * 1024); } while (0)
#define PG8_LDB(dst, b, h) do { _Pragma("unroll") for (int n = 0; n < 2; ++n) _Pragma("unroll") for (int k = 0; k < 2; ++k) dst[n][k] = *(const PG8_LAS bf16x8*)(lds + PG8_SB(b, h) + boff + n * 2048 + k * 1024); } while (0)
#define PG8_MMA(ai, bj, At, Bt) do { __builtin_amdgcn_s_setprio(1); _Pragma("unroll") for (int m = 0; m < 4; ++m) _Pragma("unroll") for (int n = 0; n < 2; ++n) _Pragma("unroll") for (int k = 0; k < 2; ++k) \
        acc[ai][bj][m][n] = __builtin_amdgcn_mfma_f32_16x16x32_bf16(Bt[n][k], At[m][k], acc[ai][bj][m][n], 0, 0, 0); __builtin_amdgcn_s_setprio(0); } while (0)
#define PG8_WAIT_V(n) asm volatile("s_waitcnt vmcnt(" #n ")" ::: "memory")
#define PG8_WAIT_L(n) asm volatile("s_waitcnt lgkmcnt(" #n ")" ::: "memory")
#define PG8_BAR __builtin_amdgcn_s_barrier()
#define PG8_SCHED __builtin_amdgcn_sched_barrier(0)
    Unit cur, nxt; int ui = 0;
    if (!S.next(0, cur)) return;
    f32x4 acc[2][2][4][2];
#pragma unroll
    for (int a = 0; a < 2; ++a)
#pragma unroll
        for (int b = 0; b < 2; ++b)
#pragma unroll
            for (int m = 0; m < 4; ++m)
#pragma unroll
                for (int n = 0; n < 2; ++n) acc[a][b][m][n] = (f32x4){0.f, 0.f, 0.f, 0.f};
    bf16x8 At[4][2], B0[2][2], B1[2][2];
    const char* cA = (const char*)g.A + (size_t)cur.pm * tstep; const char* cB = (const char*)g.Bt + (size_t)cur.pn * tstep;
    S.a_ready(cur);
    if constexpr (SP2) {
        PG8_STAGE(PG8_SB(0, 0), cB, voffB); PG8_STAGE(PG8_SB(0, 1), cB + hstep, voffB); PG8_STAGE(PG8_SA(0, 0), cA, voffA); PG8_STAGE(PG8_SA(0, 1), cA + hstep, voffA);
        if (wr == 1) PG8_BAR;
        PG8_WAIT_V(2); PG8_BAR;
        PG8_STAGE(PG8_SB(1, 0), cB + kstep, voffB); PG8_STAGE(PG8_SA(1, 0), cA + kstep, voffA); PG8_STAGE(PG8_SB(1, 1), cB + hstep + kstep, voffB);
        PG8_WAIT_V(6); PG8_BAR;
    } else {
        PG8_STAGE(PG8_SB(0, 0), cB, voffB); PG8_STAGE(PG8_SA(0, 0), cA, voffA); PG8_STAGE(PG8_SB(0, 1), cB + hstep, voffB); PG8_STAGE(PG8_SA(0, 1), cA + hstep, voffA);
        if (wr == 1) PG8_BAR;
        PG8_WAIT_V(4); PG8_BAR;
        PG8_STAGE(PG8_SB(1, 0), cB + kstep, voffB); PG8_STAGE(PG8_SA(1, 0), cA + kstep, voffA); PG8_STAGE(PG8_SB(1, 1), cB + hstep + kstep, voffB);
        PG8_WAIT_V(6); PG8_BAR;
    }
    for (;;) {
        const bool has_next = S.next(ui + 1, nxt);
        const char* nA = has_next ? (const char*)g.A + (size_t)nxt.pm * tstep : cA; const char* nB = has_next ? (const char*)g.Bt + (size_t)nxt.pn * tstep : cB;
        for (int t = 0; t < nt; t += 2) {
            const bool last = (t == nt - 2);
            const char* a1 = cA + (size_t)(t + 1) * kstep;
            const char* a2 = last ? nA : cA + (size_t)(t + 2) * kstep; const char* b2 = last ? nB : cB + (size_t)(t + 2) * kstep;
            const char* a3 = a2 + kstep; const char* b3 = b2 + kstep;
            if (last && has_next) S.a_ready(nxt);
            if constexpr (SP2) {
            PG8_LDB(B0, 0, 0); PG8_LDB(B1, 0, 1); PG8_SCHED; PG8_LDA(At, 0, 0); PG8_STAGE(PG8_SA(1, 1), a1 + hstep, voffA);
            PG8_WAIT_V(8); PG8_WAIT_L(0); PG8_BAR; PG8_MMA(0, 0, At, B0); PG8_MMA(0, 1, At, B1); PG8_BAR; PG8_SCHED;
            PG8_LDA(At, 0, 1); PG8_STAGE(PG8_SB(0, 0), b2, voffB); PG8_STAGE(PG8_SB(0, 1), b2 + hstep, voffB); PG8_STAGE(PG8_SA(0, 0), a2, voffA);
            PG8_WAIT_V(8); PG8_WAIT_L(0); PG8_BAR; PG8_MMA(1, 0, At, B0); PG8_MMA(1, 1, At, B1); PG8_BAR; PG8_SCHED;
            PG8_LDB(B0, 1, 0); PG8_LDB(B1, 1, 1); PG8_SCHED; PG8_LDA(At, 1, 0); PG8_STAGE(PG8_SA(0, 1), a2 + hstep, voffA);
            PG8_WAIT_V(8); PG8_WAIT_L(0); PG8_BAR; PG8_MMA(0, 0, At, B0); PG8_MMA(0, 1, At, B1); PG8_BAR; PG8_SCHED;
            PG8_LDA(At, 1, 1); PG8_STAGE(PG8_SB(1, 0), b3, voffB); PG8_STAGE(PG8_SB(1, 1), b3 + hstep, voffB); PG8_STAGE(PG8_SA(1, 0), a3, voffA);
            PG8_WAIT_V(8); PG8_WAIT_L(0); PG8_BAR; PG8_MMA(1, 0, At, B0); PG8_MMA(1, 1, At, B1); PG8_BAR; PG8_SCHED;
            } else {
            PG8_LDB(B0, 0, 0); PG8_SCHED; PG8_LDA(At, 0, 0); PG8_STAGE(PG8_SA(1, 1), a1 + hstep, voffA);
            PG8_WAIT_L(8); PG8_BAR; PG8_WAIT_L(0); PG8_MMA(0, 0, At, B0); PG8_BAR; PG8_SCHED;
            PG8_LDB(B1, 0, 1); PG8_STAGE(PG8_SB(0, 0), b2, voffB);
            PG8_BAR; PG8_WAIT_L(0); PG8_MMA(0, 1, At, B1); PG8_BAR;
            PG8_LDA(At, 0, 1); PG8_STAGE(PG8_SA(0, 0), a2, voffA);
            PG8_BAR; PG8_WAIT_L(0); PG8_MMA(1, 0, At, B0); PG8_BAR; PG8_SCHED;
            PG8_STAGE(PG8_SB(0, 1), b2 + hstep, voffB);
            PG8_WAIT_V(6); PG8_BAR; PG8_MMA(1, 1, At, B1); PG8_BAR;
            PG8_LDB(B0, 1, 0); PG8_SCHED; PG8_LDA(At, 1, 0); PG8_STAGE(PG8_SA(0, 1), a2 + hstep, voffA);
            PG8_WAIT_L(8); PG8_BAR; PG8_WAIT_L(0); PG8_MMA(0, 0, At, B0); PG8_BAR; PG8_SCHED;
            PG8_LDB(B1, 1, 1); PG8_STAGE(PG8_SB(1, 0), b3, voffB);
            PG8_BAR; PG8_WAIT_L(0); PG8_MMA(0, 1, At, B1); PG8_BAR;
            PG8_LDA(At, 1, 1); PG8_STAGE(PG8_SA(1, 0), a3, voffA);
            PG8_BAR; PG8_WAIT_L(0); PG8_MMA(1, 0, At, B0); PG8_BAR; PG8_SCHED;
            PG8_STAGE(PG8_SB(1, 1), b3 + hstep, voffB);
            PG8_WAIT_V(6); PG8_BAR; PG8_MMA(1, 1, At, B1); PG8_BAR;
            }
        }
        if constexpr (ALIGN_EPI) { if (wr == 0) PG8_BAR; }
        if constexpr (!Epi::AFTER_DRAIN) { E(acc, cur, wr, wc, fr, fq); S.done(cur); }
        if (!has_next) break;
#pragma unroll
        for (int a = 0; a < 2; ++a)
#pragma unroll
            for (int b = 0; b < 2; ++b)
#pragma unroll
                for (int m = 0; m < 4; ++m)
#pragma unroll
                    for (int n = 0; n < 2; ++n) acc[a][b][m][n] = (f32x4){0.f, 0.f, 0.f, 0.f};
        cur = nxt; cA = nA; cB = nB; ++ui;
        if constexpr (ALIGN_EPI) { if (wr == 1) PG8_BAR; }
    }
    PG8_WAIT_V(0);
    if constexpr (!ALIGN_EPI) { if (wr == 0) PG8_BAR; }
    PG8_BAR;
    if constexpr (Epi::AFTER_DRAIN) { E.fused(acc, cur, wr, wc, fr, fq, lds, wid, lane); S.done(cur); }
#undef PG8_SA
#undef PG8_SB
#undef PG8_STAGE
#undef PG8_LDA
#undef PG8_LDB
#undef PG8_MMA
#undef PG8_WAIT_V
#undef PG8_WAIT_L
#undef PG8_BAR
#undef PG8_SCHED
}
}
#define GAS __attribute__((address_space(1)))
#define LAS __attribute__((address_space(3)))
typedef unsigned short bf16;
typedef unsigned v4u __attribute__((ext_vector_type(4)));
typedef float f32x4 __attribute__((ext_vector_type(4)));
typedef short bf16x8 __attribute__((ext_vector_type(8)));
typedef GAS unsigned gu32;
typedef GAS unsigned long long gu64;
#define RLX_AGENT __ATOMIC_RELAXED, __HIP_MEMORY_SCOPE_AGENT
#define LDS_WAIT() asm volatile("s_waitcnt lgkmcnt(0)" ::: "memory")
#define VM_WAIT() asm volatile("s_waitcnt vmcnt(0)" ::: "memory")
__device__ __forceinline__ unsigned long long rt() { return __builtin_amdgcn_s_memrealtime(); }
__device__ __forceinline__ unsigned f2bf(float f) { unsigned u = __builtin_bit_cast(unsigned, f); return (u + 0x7fffu + ((u >> 16) & 1u)) >> 16; }
__device__ __forceinline__ unsigned pk2(float lo, float hi) { return f2bf(lo) | (f2bf(hi) << 16); }

#define XB_TMO      128
#define XB_XCNT(j)  (256  + 64 * (j))
#define XB_XSUB(j)  (1280 + 64 * (j))
#define XB_XGEN(j)  (2304 + 64 * (j))
#define XB_TOP      3328
#define XB_TOPGEN   3392
#define XCD_BAR_WORDS 3456
#define XB_SPIN_CAP (1u << 18)

__device__ __forceinline__ unsigned xb_ld(unsigned* p)              { return __hip_atomic_load(p, __ATOMIC_RELAXED, __HIP_MEMORY_SCOPE_AGENT); }
__device__ __forceinline__ unsigned xb_add(unsigned* p, unsigned v) { return __hip_atomic_fetch_add(p, v, __ATOMIC_RELAXED, __HIP_MEMORY_SCOPE_AGENT); }
__device__ __forceinline__ unsigned xb_xcc_id() { return (unsigned)__builtin_amdgcn_s_getreg((3 << 11) | 20) & 0xFu; }
#define XB_SPIN(cond, bar) do { unsigned _sp = 0; while (cond) { __builtin_amdgcn_s_sleep(1); \
    if ((++_sp & 255u) == 0u) { if (xb_ld(&(bar)[XB_TMO])) break; if (_sp > XB_SPIN_CAP) { atomicAdd(&(bar)[XB_TMO], 1u); break; } } } } while (0)

struct XcdBarrier {
    unsigned* bar; unsigned x;
    volatile LAS unsigned* st;
};

__device__ __forceinline__ XcdBarrier xcd_barrier_post(unsigned* bar, volatile LAS unsigned* st) {
    XcdBarrier b; b.bar = bar; b.x = xb_xcc_id(); b.st = st;
    if (threadIdx.x == 0) (void)xb_add(&bar[XB_XCNT(b.x)], 1u);
    return b;
}
__device__ __forceinline__ void xcd_barrier_complete(unsigned* bar, unsigned x, unsigned& nloc, unsigned& nx) {
    const unsigned G = gridDim.x * gridDim.y * gridDim.z;
    unsigned sum, cnt, mine, sp = 0u;
    for (;;) {
        sum = 0u; cnt = 0u; mine = 0u;
#pragma unroll
        for (unsigned j = 0; j < 16; ++j) { const unsigned c = xb_ld(&bar[XB_XCNT(j)]); sum += c; cnt += (c > 0u) ? 1u : 0u; mine = (j == x) ? c : mine; }
        if (sum == G) break;
        __builtin_amdgcn_s_sleep(1);
        if ((++sp & 255u) == 0u) { if (xb_ld(&bar[XB_TMO])) break; if (sp > XB_SPIN_CAP) { atomicAdd(&bar[XB_TMO], 1u); break; } }
    }
    nloc = mine > 0u ? mine : 1u; nx = cnt > 0u ? cnt : 1u;
}

__device__ __forceinline__ void xcd_barrier(const XcdBarrier& b) {
    asm volatile("s_waitcnt vmcnt(0)" ::: "memory");
    __syncthreads();
    if (threadIdx.x == 0) {
        unsigned* bar = b.bar;
        __builtin_amdgcn_s_waitcnt(0);
        unsigned nloc = b.st[0], nx = b.st[1];
        if (nloc == 0u) { xcd_barrier_complete(bar, b.x, nloc, nx); b.st[0] = nloc; b.st[1] = nx; }
        const unsigned old = xb_add(&bar[XB_XSUB(b.x)], 1u);
        const unsigned gen = old / nloc;
        if (old + 1u == (gen + 1u) * nloc) {
            __builtin_amdgcn_fence(__ATOMIC_RELEASE, "agent");
            asm volatile("s_waitcnt vmcnt(0)" ::: "memory");
            const unsigned og = xb_add(&bar[XB_TOP], 1u);
            const unsigned tg = og / nx;
            if (og + 1u == (tg + 1u) * nx) xb_add(&bar[XB_TOPGEN], 1u);
            else XB_SPIN(xb_ld(&bar[XB_TOPGEN]) == tg, bar);
            __builtin_amdgcn_fence(__ATOMIC_ACQUIRE, "agent");
            xb_add(&bar[XB_XGEN(b.x)], 1u);
            asm volatile("s_waitcnt vmcnt(0)" ::: "memory");
        } else {
            XB_SPIN(xb_ld(&bar[XB_XGEN(b.x)]) == gen, bar);
            __builtin_amdgcn_fence(__ATOMIC_ACQUIRE, "agent");
            asm volatile("s_waitcnt vmcnt(0)" ::: "memory");
        }
    }
    __syncthreads();
}

constexpr int NWAVES = 8;
constexpr int BATCH = 8, SEQ = 8192, DM = 1024, M = BATCH * SEQ;
constexpr int DIN = 4360, NIN = 4352;
constexpr float EPS = 1e-6f;
#ifndef MK_N_LAUNCHES
#define MK_N_LAUNCHES 9
#endif
constexpr int N_PHASES = 9;
constexpr int N_LAUNCHES = MK_N_LAUNCHES;

constexpr size_t MiB = 1u << 20;
constexpr size_t WS_CTL = 0, CTL_ZERO_BYTES = 1 * MiB;
constexpr size_t WS_SS1 = 512 * 1024;
constexpr size_t WS_WIN = 2 * MiB;
constexpr size_t WIN_BYTES = (size_t)NIN * 1024 * 2;
constexpr size_t WS_WG = 20 * MiB;
constexpr size_t WS_WOUT = 21 * MiB;
constexpr size_t WS_SS0 = 26 * MiB;
constexpr size_t WS_IG = 27 * MiB, WS_LF = 28 * MiB;
constexpr size_t WS_XN = 128 * MiB;
constexpr size_t WS_AQ = 256 * MiB, WS_AK = 288 * MiB, WS_AV = 320 * MiB, WS_AZ = 352 * MiB;
constexpr size_t WS_MQ = 384 * MiB, WS_MK = 448 * MiB, WS_MV = 512 * MiB, WS_MO = 576 * MiB, WS_MZ = 640 * MiB;
constexpr size_t WS_CU = 704 * MiB, WS_CZ = 736 * MiB;
constexpr size_t WS_MIX = 768 * MiB;
constexpr size_t WS_HB = 896 * MiB;
constexpr size_t WS_END = 1024 * MiB;
constexpr int CW_TMO = 0, CW_CODE = 1;
constexpr int CW_BAR = 4096;

constexpr int RING_OFF = 0, RING_BYTES = 131072;
constexpr int LDSCTL_OFF = RING_BYTES, MISC_OFF = LDSCTL_OFF + 320;
constexpr int LDS_BYTES = 147456;


struct Frame {
    LAS unsigned char* lds;
    volatile LAS unsigned* MISC;
    gu32* ctl;
    int tid, lane, wave;
    int vcu, G;
    unsigned char* ws;
};
#define IN_X(a) ((a).in[0])
#define IN_NORM_G(a) ((a).in[1])
#define IN_W_IN(a) ((a).in[2])
#define IN_ATT_Q_G(a) ((a).in[3])
#define IN_ATT_K_G(a) ((a).in[4])
#define IN_REL_BIAS(a) ((a).in[5])
#define IN_ML_CONV_W(a) ((a).in[6])
#define IN_ML_CONV_B(a) ((a).in[7])
#define IN_ML_B_I(a) ((a).in[8])
#define IN_ML_B_F(a) ((a).in[9])
#define IN_ML_OUT_G(a) ((a).in[10])
#define IN_CV_DW_W(a) ((a).in[11])
#define IN_CV_DW_B(a) ((a).in[12])
#define IN_CV_LN_G(a) ((a).in[13])
#define IN_CV_LN_B(a) ((a).in[14])
#define IN_W_OUT(a) ((a).in[15])
struct Args { const float* in[16]; float* out; unsigned char* ws; int ph_lo, ph_hi, li, pad; };
__device__ __forceinline__ float bf2f(unsigned short h) { return __uint_as_float((unsigned)h << 16); }
__device__ __forceinline__ float bflo(unsigned w) { return __uint_as_float(w << 16); }
__device__ __forceinline__ float bfhi(unsigned w) { return __uint_as_float(w & 0xffff0000u); }
__device__ __forceinline__ float wave_sum(float v) {
#pragma unroll
    for (int o = 1; o < 64; o <<= 1) v += __shfl_xor(v, o);
    return v;
}
__device__ __forceinline__ float wave_max(float v) {
#pragma unroll
    for (int o = 1; o < 64; o <<= 1) v = fmaxf(v, __shfl_xor(v, o));
    return v;
}
__device__ __forceinline__ float sigm(float x) { return 1.0f / (1.0f + __expf(-x)); }

__device__ __forceinline__ int in_src_col(int j, int g) {
    const int bj = g >> 2, wc = g & 3;
    if (j < 4) return 256 * j + 64 * wc + 32 * bj;
    if (j < 14) return 1024 + 512 * ((j - 4) >> 1) + 256 * ((j - 4) & 1) + 64 * wc + 32 * bj;
    if (j < 16) return (bj == 0 ? 3592 : 3848) + 128 * (j - 14) + 32 * wc;
    return 4104 + 64 * wc + 32 * bj;
}
__device__ __forceinline__ void p0_transpose_item(const float* W, int ldw, int src0, int k0, const float* gain, bf16* WT, int K, int n0, LAS float* scr, int lane) {
#pragma unroll 8
    for (int i = 0; i < 32; ++i) { const int kk = 2 * i + (lane >> 5); float v = W[(size_t)(k0 + kk) * ldw + src0 + (lane & 31)]; if (gain) v *= gain[k0 + kk]; scr[kk * 33 + (lane & 31)] = v; }
    LDS_WAIT(); asm volatile("" ::: "memory");
    const int c = lane & 7;
#pragma unroll
    for (int jj = 0; jj < 4; ++jj) { const int n = (lane >> 3) + 8 * jj; const LAS float* s = scr + (8 * c) * 33 + n;
        v4u o; o.x = pk2(s[0 * 33], s[1 * 33]); o.y = pk2(s[2 * 33], s[3 * 33]); o.z = pk2(s[4 * 33], s[5 * 33]); o.w = pk2(s[6 * 33], s[7 * 33]);
        *(GAS v4u*)(WT + (size_t)(n0 + n) * K + k0 + 8 * c) = o; }
    LDS_WAIT(); asm volatile("" ::: "memory");
}
__device__ __forceinline__ void p0_prologue(Frame& F, const Args& A) {
    LAS float* scr = (LAS float*)(F.lds + RING_OFF + F.wave * 16384);
    const int gw = F.vcu * NWAVES + F.wave, NGW = F.G * NWAVES;
    constexpr int I_IN = 16 * (NIN / 32), I_OUT = 16 * 32, I_L = I_IN + I_OUT;
    for (int it = gw; it < 2 * I_L; it += NGW) {
        const int l = it / I_L; int r = it % I_L;
        if (r < I_IN) { const int kb = r / (NIN / 32), ng = r % (NIN / 32);
            p0_transpose_item(IN_W_IN(A) + (size_t)l * 1024 * DIN, DIN, in_src_col(ng >> 3, ng & 7), 64 * kb, IN_NORM_G(A) + l * 1024, (bf16*)(F.ws + WS_WIN + l * WIN_BYTES), 1024, 32 * ng, scr, F.lane); }
        else { r -= I_IN; const int kb = r / 32, nb = r % 32;
            p0_transpose_item(IN_W_OUT(A) + (size_t)l * 1024 * 1024, 1024, 32 * nb, 64 * kb, nullptr, (bf16*)(F.ws + WS_WOUT + (size_t)l * 2 * MiB), 1024, 32 * nb, scr, F.lane); }
    }
    { float* WG = (float*)(F.ws + WS_WG);
      for (int e = gw * 64 + F.lane; e < 2 * 8 * 1024; e += NGW * 64) { const int l = e >> 13, j = (e >> 10) & 7, k = e & 1023;
          WG[e] = IN_NORM_G(A)[l * 1024 + k] * IN_W_IN(A)[(size_t)l * 1024 * DIN + (size_t)k * DIN + 3584 + j]; } }
    bf16* XN = (bf16*)(F.ws + WS_XN); float* SS0 = (float*)(F.ws + WS_SS0);
    for (int m = gw; m < M; m += NGW) {
        const GAS f32x4* xr = (const GAS f32x4*)(IN_X(A) + (size_t)m * DM) + F.lane;
        f32x4 v[4]; float s2 = 0.f;
#pragma unroll
        for (int j = 0; j < 4; ++j) { v[j] = xr[64 * j]; s2 += (v[j].x * v[j].x + v[j].y * v[j].y) + (v[j].z * v[j].z + v[j].w * v[j].w); }
        s2 = wave_sum(s2);
        GAS unsigned long long* o8 = (GAS unsigned long long*)(XN + (size_t)m * DM) + F.lane;
#pragma unroll
        for (int j = 0; j < 4; ++j) o8[64 * j] = (unsigned long long)pk2(v[j].x, v[j].y) | ((unsigned long long)pk2(v[j].z, v[j].w) << 32);
        if (F.lane == 0) SS0[m] = s2;
    }
}

__device__ __forceinline__ void gates_phase(Frame& F, const Args& A, int l, const float* ss) {
    const int gw = F.vcu * NWAVES + F.wave, NGW = F.G * NWAVES;
    const float* WG = (const float*)(F.ws + WS_WG) + l * 8192;
    const bf16* XN = (const bf16*)(F.ws + WS_XN);
    float* IG = (float*)(F.ws + WS_IG); float* LF = (float*)(F.ws + WS_LF);
    f32x4 w[8][2][2];
#pragma unroll
    for (int j = 0; j < 8; ++j)
#pragma unroll
        for (int hlf = 0; hlf < 2; ++hlf) { w[j][hlf][0] = *(const f32x4*)(WG + j * 1024 + 512 * hlf + 8 * F.lane); w[j][hlf][1] = *(const f32x4*)(WG + j * 1024 + 512 * hlf + 8 * F.lane + 4); }
    const float bi = IN_ML_B_I(A)[l * 4 + (F.lane & 3)], bfv = IN_ML_B_F(A)[l * 4 + (F.lane & 3)];
    for (int m = gw; m < M; m += NGW) {
        const v4u* xp = (const v4u*)(XN + (size_t)m * DM + 8 * F.lane);
        const v4u xa = xp[0], xb = xp[64];
        float xf[2][8];
        xf[0][0] = bflo(xa.x); xf[0][1] = bfhi(xa.x); xf[0][2] = bflo(xa.y); xf[0][3] = bfhi(xa.y); xf[0][4] = bflo(xa.z); xf[0][5] = bfhi(xa.z); xf[0][6] = bflo(xa.w); xf[0][7] = bfhi(xa.w);
        xf[1][0] = bflo(xb.x); xf[1][1] = bfhi(xb.x); xf[1][2] = bflo(xb.y); xf[1][3] = bfhi(xb.y); xf[1][4] = bflo(xb.z); xf[1][5] = bfhi(xb.z); xf[1][6] = bflo(xb.w); xf[1][7] = bfhi(xb.w);
        float d[8];
#pragma unroll
        for (int j = 0; j < 8; ++j) { float s = 0.f;
#pragma unroll
            for (int hlf = 0; hlf < 2; ++hlf)
#pragma unroll
                for (int e = 0; e < 8; ++e) s += xf[hlf][e] * w[j][hlf][e >> 2][e & 3];
            d[j] = wave_sum(s); }
        const float rstd = 1.0f / sqrtf(ss[m] * (1.0f / 1024.0f) + EPS);
        const int h = F.lane & 3;
        const float di = (h == 0) ? d[0] : (h == 1) ? d[1] : (h == 2) ? d[2] : d[3];
        const float df = (h == 0) ? d[4] : (h == 1) ? d[5] : (h == 2) ? d[6] : d[7];
        if (F.lane < 4) { IG[(size_t)m * 4 + h] = di * rstd + bi;
            const float fp = df * rstd + bfv;
            LF[(size_t)m * 4 + h] = fminf(fp, 0.f) - log1pf(__expf(-fabsf(fp))); }
    }
}

__device__ __forceinline__ void attn_v1(Frame& F, const Args& A, int l) {
    int lane_ = F.lane; asm volatile("" : "+v"(lane_)); const int gw = F.vcu * NWAVES + F.wave, NGW = F.G * NWAVES, lane = lane_;
    const bf16* AQ = (const bf16*)(F.ws + WS_AQ); const bf16* AK = (const bf16*)(F.ws + WS_AK); const bf16* AV = (const bf16*)(F.ws + WS_AV); const bf16* AZ = (const bf16*)(F.ws + WS_AZ);
    bf16* MIX = (bf16*)(F.ws + WS_MIX);
    for (int it = gw; it < M * 4; it += NGW) {
        const int m = it >> 2, h = it & 3, b = m >> 13, t = m & 8191, c = t >> 6, i = t & 63;
        const float* bias = IN_REL_BIAS(A) + (l * 4 + h) * 257;
        float q[64];
        { const v4u* qp = (const v4u*)(AQ + (size_t)m * 256 + 64 * h);
#pragma unroll
          for (int cc = 0; cc < 8; ++cc) { const v4u w = qp[cc]; q[8 * cc + 0] = bflo(w.x); q[8 * cc + 1] = bfhi(w.x); q[8 * cc + 2] = bflo(w.y); q[8 * cc + 3] = bfhi(w.y); q[8 * cc + 4] = bflo(w.z); q[8 * cc + 5] = bfhi(w.z); q[8 * cc + 6] = bflo(w.w); q[8 * cc + 7] = bfhi(w.w); } }
        float s[9]; float mx = -3.0e38f;
#pragma unroll
        for (int g = 0; g < 9; ++g) {
            const int cb = c - 8 + g;
            if (cb >= 0) {
                const int row = b * SEQ + 64 * cb + lane;
                const v4u* kp = (const v4u*)(AK + (size_t)row * 256 + 64 * h);
                float dot = 0.f;
#pragma unroll
                for (int cc = 0; cc < 8; ++cc) { const v4u w = kp[cc];
                    dot += q[8 * cc + 0] * bflo(w.x) + q[8 * cc + 1] * bfhi(w.x) + q[8 * cc + 2] * bflo(w.y) + q[8 * cc + 3] * bfhi(w.y)
                         + q[8 * cc + 4] * bflo(w.z) + q[8 * cc + 5] * bfhi(w.z) + q[8 * cc + 6] * bflo(w.w) + q[8 * cc + 7] * bfhi(w.w); }
                int rel = i - (64 * g + lane) + 512; rel = rel < -128 ? -128 : (rel > 128 ? 128 : rel);
                s[g] = dot + bias[rel + 128];
                mx = fmaxf(mx, s[g]);
            } else s[g] = -3.0e38f;
        }
        mx = wave_max(mx);
        float lsum = 0.f;
#pragma unroll
        for (int g = 0; g < 9; ++g) { s[g] = (c - 8 + g >= 0) ? __expf(s[g] - mx) : 0.f; lsum += s[g]; }
        lsum = wave_sum(lsum);
        float o = 0.f;
#pragma unroll
        for (int g = 0; g < 9; ++g) {
            const int cb = c - 8 + g;
            if (cb >= 0) {
                const bf16* vp = AV + (size_t)(b * SEQ + 64 * cb) * 256 + 64 * h + lane;
                for (int jj = 0; jj < 64; ++jj) { const float pj = __shfl(s[g], jj); o += pj * bf2f(vp[(size_t)jj * 256]); }
            }
        }
        const float r = o / lsum * bf2f(AZ[(size_t)m * 256 + 64 * h + lane]);
        MIX[(size_t)m * 1024 + 64 * h + lane] = (bf16)f2bf(r);
    }
}

__device__ __forceinline__ void conv_v1(Frame& F, const Args& A, int l) {
    int lane_ = F.lane; asm volatile("" : "+v"(lane_)); const int gw = F.vcu * NWAVES + F.wave, NGW = F.G * NWAVES, lane = lane_;
    const bf16* CU = (const bf16*)(F.ws + WS_CU); const bf16* CZ = (const bf16*)(F.ws + WS_CZ); bf16* MIX = (bf16*)(F.ws + WS_MIX);
    const float* W = IN_CV_DW_W(A) + l * 31 * 256;
    for (int m = gw; m < M; m += NGW) {
        const int b = m >> 13, t = m & 8191;
        float a[4];
#pragma unroll
        for (int k = 0; k < 4; ++k) a[k] = IN_CV_DW_B(A)[l * 256 + lane + 64 * k];
        for (int j = 0; j < 31; ++j) { const int tt = t - 30 + j;
            if (tt >= 0) { const bf16* up = CU + (size_t)(b * SEQ + tt) * 256 + lane;
#pragma unroll
                for (int k = 0; k < 4; ++k) a[k] += bf2f(up[64 * k]) * W[j * 256 + lane + 64 * k]; } }
        const float mean = wave_sum((a[0] + a[1]) + (a[2] + a[3])) * (1.0f / 256.0f);
        float q = 0.f;
#pragma unroll
        for (int k = 0; k < 4; ++k) { a[k] -= mean; q += a[k] * a[k]; }
        const float rstd = 1.0f / sqrtf(wave_sum(q) * (1.0f / 256.0f) + EPS);
#pragma unroll
        for (int k = 0; k < 4; ++k) { const int ch = lane + 64 * k; float y = a[k] * rstd * IN_CV_LN_G(A)[l * 256 + ch] + IN_CV_LN_B(A)[l * 256 + ch];
            y = y * sigm(y); y *= bf2f(CZ[(size_t)m * 256 + ch]);
            MIX[(size_t)m * 1024 + 768 + ch] = (bf16)f2bf(y); }
    }
}

__device__ __forceinline__ void mlstm_v1(Frame& F, const Args& A, int l) {
    const bf16* MQ = (const bf16*)(F.ws + WS_MQ); const bf16* MK = (const bf16*)(F.ws + WS_MK); const bf16* MV = (const bf16*)(F.ws + WS_MV);
    const float* IG = (const float*)(F.ws + WS_IG); const float* LF = (const float*)(F.ws + WS_LF); float* HB = (float*)(F.ws + WS_HB);
    int tid_ = F.tid; asm volatile("" : "+v"(tid_)); const int vv = tid_ >> 5, kg = tid_ & 31;
    for (int it = blockIdx.x; it < 256; it += F.G) {
        const int b = it >> 5, h = (it >> 3) & 3, vs = it & 7;
        float cwq[4][4], cwk[4][4], cbq[4], cbk[4];
#pragma unroll
        for (int e = 0; e < 4; ++e) { const int ch = 128 * h + 4 * kg + e;
            cbq[e] = IN_ML_CONV_B(A)[l * 1024 + ch]; cbk[e] = IN_ML_CONV_B(A)[l * 1024 + 512 + ch];
#pragma unroll
            for (int j = 0; j < 4; ++j) { cwq[j][e] = IN_ML_CONV_W(A)[l * 4096 + j * 1024 + ch]; cwk[j][e] = IN_ML_CONV_W(A)[l * 4096 + j * 1024 + 512 + ch]; } }
        float pq[3][4], pk[3][4];
#pragma unroll
        for (int j = 0; j < 3; ++j)
#pragma unroll
            for (int e = 0; e < 4; ++e) { pq[j][e] = 0.f; pk[j][e] = 0.f; }
        float C[4] = {0.f, 0.f, 0.f, 0.f}, n[4] = {0.f, 0.f, 0.f, 0.f}, mst = 0.f;
        const size_t rb = (size_t)b * SEQ;
        for (int t0 = 0; t0 < SEQ; t0 += 8) {
            typedef unsigned u32x2v __attribute__((ext_vector_type(2)));
            u32x2v rq[8], rk[8]; unsigned short rv[8]; float rig[8], rlf[8];
#pragma unroll
            for (int s = 0; s < 8; ++s) { const size_t row = rb + t0 + s;
                rq[s] = *(const u32x2v*)(MQ + row * 512 + 128 * h + 4 * kg); rk[s] = *(const u32x2v*)(MK + row * 512 + 128 * h + 4 * kg);
                rv[s] = MV[row * 512 + 128 * h + 16 * vs + vv]; rig[s] = IG[row * 4 + h]; rlf[s] = LF[row * 4 + h]; }
#pragma unroll
            for (int s = 0; s < 8; ++s) {
                float cq[4] = {bflo(rq[s].x), bfhi(rq[s].x), bflo(rq[s].y), bfhi(rq[s].y)}, ck[4] = {bflo(rk[s].x), bfhi(rk[s].x), bflo(rk[s].y), bfhi(rk[s].y)};
                float qv[4], kv[4];
#pragma unroll
                for (int e = 0; e < 4; ++e) {
                    float aq = cbq[e] + pq[0][e] * cwq[0][e] + pq[1][e] * cwq[1][e] + pq[2][e] * cwq[2][e] + cq[e] * cwq[3][e];
                    float ak = cbk[e] + pk[0][e] * cwk[0][e] + pk[1][e] * cwk[1][e] + pk[2][e] * cwk[2][e] + ck[e] * cwk[3][e];
                    qv[e] = aq * sigm(aq); kv[e] = ak * sigm(ak) * 0.08838834764831845f;
                    pq[0][e] = pq[1][e]; pq[1][e] = pq[2][e]; pq[2][e] = cq[e]; pk[0][e] = pk[1][e]; pk[1][e] = pk[2][e]; pk[2][e] = ck[e];
                }
                const float vt = bf2f(rv[s]), ig = rig[s], lf = rlf[s];
                const float mn = fmaxf(lf + mst, ig), fp = __expf(lf + mst - mn), ip = __expf(ig - mn);
                float num = 0.f, den = 0.f;
#pragma unroll
                for (int e = 0; e < 4; ++e) { C[e] = fp * C[e] + ip * vt * kv[e]; n[e] = fp * n[e] + ip * kv[e]; num += C[e] * qv[e]; den += n[e] * qv[e]; }
#pragma unroll
                for (int o = 1; o < 32; o <<= 1) { num += __shfl_xor(num, o); den += __shfl_xor(den, o); }
                mst = mn;
                if (kg == 0) HB[(rb + t0 + s) * 512 + 128 * h + 16 * vs + vv] = num / fmaxf(fabsf(den), __expf(-mn));
            }
        }
    }
}
__device__ __forceinline__ void mlfin_v1(Frame& F, const Args& A, int l) {
    int lane_ = F.lane; asm volatile("" : "+v"(lane_)); const int gw = F.vcu * NWAVES + F.wave, NGW = F.G * NWAVES, lane = lane_;
    const bf16* MO = (const bf16*)(F.ws + WS_MO); const bf16* MZ = (const bf16*)(F.ws + WS_MZ); const float* HB = (const float*)(F.ws + WS_HB); bf16* MIX = (bf16*)(F.ws + WS_MIX);
    for (int it = gw; it < M * 4; it += NGW) {
        const int m = it >> 2, h = it & 3;
        float v[2]; float q = 0.f;
#pragma unroll
        for (int k = 0; k < 2; ++k) { const size_t o = (size_t)m * 512 + 128 * h + lane + 64 * k; v[k] = bf2f(MO[o]) * HB[o]; q += v[k] * v[k]; }
        const float rstd = 1.0f / sqrtf(wave_sum(q) * (1.0f / 128.0f) + EPS);
#pragma unroll
        for (int k = 0; k < 2; ++k) { const int ch = 128 * h + lane + 64 * k;
            const float y = v[k] * rstd * IN_ML_OUT_G(A)[l * 512 + ch] * bf2f(MZ[(size_t)m * 512 + ch]);
            MIX[(size_t)m * 1024 + 256 + ch] = (bf16)f2bf(y); }
    }
}

__global__ void __launch_bounds__(NWAVES * 64, 2) skel_fwd(Args args) {
    extern __shared__ __attribute__((aligned(16))) unsigned char lds[];
    Frame F;
    F.lds = (LAS unsigned char*)lds;
    F.MISC = (volatile LAS unsigned*)(F.lds + MISC_OFF);
    F.tid = threadIdx.x; F.lane = F.tid & 63; F.wave = __builtin_amdgcn_readfirstlane(F.tid >> 6);
    F.G = gridDim.x; { const int bx = blockIdx.x; F.vcu = (F.G % 8 == 0) ? (bx % 8) * (F.G / 8) + bx / 8 : bx; }
    unsigned char* ws = args.ws; F.ws = ws;
    F.ctl = (gu32*)(ws + WS_CTL);
    for (int u = F.tid; u < (LDS_BYTES - LDSCTL_OFF) / 4; u += NWAVES * 64) ((LAS unsigned*)(F.lds + LDSCTL_OFF))[u] = 0u;
    __syncthreads();
    XcdBarrier bar; bar.bar = (unsigned*)(F.ctl + CW_BAR); bar.x = 0; bar.st = nullptr;
    if (N_LAUNCHES == 1) bar = xcd_barrier_post((unsigned*)(F.ctl + CW_BAR), F.MISC + 8);
#define GRID_BAR() do { if (N_LAUNCHES == 1) xcd_barrier(bar); } while (0)
    const int lo = args.ph_lo, hi = args.ph_hi;
#define IN(k) (lo <= (k) && (k) < hi)
#define BOTH(k) (IN(k) && IN((k) + 1))
    if (IN(0)) { p0_prologue(F, args); if (BOTH(0)) GRID_BAR(); }
#pragma unroll 1
    for (int l = 0; l < 2; ++l) {
        const int p = 1 + 4 * l;
        const float* ss = (l == 0) ? (const float*)(ws + WS_SS0) : (const float*)(ws + WS_SS1);
        if (IN(p)) {
            pg8::Gemm g{(const pg8::bf16_t*)(ws + WS_XN), (const pg8::bf16_t*)(ws + WS_WIN + l * WIN_BYTES), M, NIN, 1024}; pg8::StaticOrder S; S.init(M, NIN, F.G, (int)blockIdx.x);
            pg8::EpiIn E{ws, ss, IN_ATT_Q_G(args) + l * 64, IN_ATT_K_G(args) + l * 64, 0.125f};
            pg8::gemm_phase<pg8::EpiIn, pg8::StaticOrder, true, true>(F.lds + RING_OFF, g, S, E);
            gates_phase(F, args, l, ss);
            if (BOTH(p)) GRID_BAR();
        }
        if (IN(p + 1)) { attn_v1(F, args, l); conv_v1(F, args, l); mlstm_v1(F, args, l); if (BOTH(p + 1)) GRID_BAR(); }
        if (IN(p + 2)) { mlfin_v1(F, args, l); if (BOTH(p + 2)) GRID_BAR(); }
        if (IN(p + 3)) {
            pg8::Gemm g{(const pg8::bf16_t*)(ws + WS_MIX), (const pg8::bf16_t*)(ws + WS_WOUT + (size_t)l * 2 * MiB), M, DM, 1024}; pg8::StaticOrder S; S.init(M, DM, F.G, (int)blockIdx.x);
            pg8::EpiOut E{(l == 0) ? IN_X(args) : (const float*)args.out, args.out, (l == 0) ? (pg8::bf16_t*)(ws + WS_XN) : nullptr, (float*)(ws + WS_SS1)};
            pg8::gemm_phase<pg8::EpiOut, pg8::StaticOrder, true, true>(F.lds + RING_OFF, g, S, E);
            if (BOTH(p + 3)) GRID_BAR();
        }
    }
#undef IN
#undef BOTH
}

extern "C" void kernel_launch(void* const* d_in, const int* in_sizes, int n_in, void* d_out, int out_size, void* d_ws, size_t ws_size, hipStream_t stream) {
    static int grid = 0;
    if (grid == 0) {
        if (n_in != 16 || in_sizes[0] != M * DM || out_size != M * DM || ws_size < WS_END) { fprintf(stderr, "kernel_launch: unexpected shapes: n_in %d in0 %d out %d ws %zu\n", n_in, n_in > 0 ? in_sizes[0] : -1, out_size, ws_size); grid = -1; return; }
        int dev = 0, cus = 0;
        if (hipGetDevice(&dev) != hipSuccess || hipDeviceGetAttribute(&cus, hipDeviceAttributeMultiprocessorCount, dev) != hipSuccess) { grid = -1; return; }
        if (hipFuncSetAttribute((const void*)skel_fwd, hipFuncAttributeMaxDynamicSharedMemorySize, LDS_BYTES) != hipSuccess) { fprintf(stderr, "kernel_launch: hipFuncSetAttribute failed\n"); grid = -1; return; }
        int per_cu = 0;
        if (hipOccupancyMaxActiveBlocksPerMultiprocessor(&per_cu, (const void*)skel_fwd, NWAVES * 64, LDS_BYTES) != hipSuccess || per_cu < 1) fprintf(stderr, "kernel_launch: occupancy query reports %d\n", per_cu);
        (void)hipGetLastError();
        grid = cus;
    }
    if (grid < 0) return;
    if (hipMemsetAsync((char*)d_ws + WS_CTL, 0, CTL_ZERO_BYTES, stream) != hipSuccess) return;
    Args a{};
    for (int i = 0; i < 16; ++i) a.in[i] = (const float*)d_in[i];
    a.out = (float*)d_out; a.ws = (unsigned char*)d_ws;
    for (int li = 0; li < N_LAUNCHES; ++li) {
        a.ph_lo = (N_LAUNCHES == 1) ? 0 : li; a.ph_hi = (N_LAUNCHES == 1) ? N_PHASES : li + 1; a.li = li;
        hipLaunchKernelGGL(skel_fwd, dim3(grid), dim3(NWAVES * 64), LDS_BYTES, stream, a);
    }
}
```

```cpp
#include <hip/hip_runtime.h>
#include <cstdio>
#include <cstdint>
#ifndef MK_N_LAUNCHES
#define MK_N_LAUNCHES 1
#endif
namespace pg8 {
#define PG8_LAS __attribute__((address_space(3)))
typedef unsigned short bf16_t;
typedef short bf16x8 __attribute__((ext_vector_type(8)));
typedef float f32x4 __attribute__((ext_vector_type(4)));
typedef unsigned u32x4 __attribute__((ext_vector_type(4)));
constexpr int BM = 256, BK = 64, HALF = 128, HTB = HALF * BK * 2  , STAGE_BYTES = 8 * HTB, NXCD = 8, WGM = 8;

__host__ __device__ __forceinline__ int lds_byte(int r, int c) { const int st = (r >> 4) * 2 + (c >> 5), rr = r & 15, cc = c & 31, ob = rr * 64 + cc * 2; return st * 1024 + (ob ^ (((ob >> 9) & 1) << 5)); }
__host__ __device__ __forceinline__ void stage_rc(int b, int& R, int& C) { const int st = b / 1024, sb = b % 1024, swz = sb ^ (((sb >> 9) & 1) << 5); R = (st >> 1) * 16 + swz / 64; C = (st & 1) * 32 + (swz % 64) / 2; }
__host__ __device__ __forceinline__ int perm32(int rho) { const int n = rho >> 4, i = rho & 15; return 8 * (i >> 2) + 4 * n + (i & 3); }

struct Unit { int pm, pn; };
struct Gemm { const bf16_t* A; const bf16_t* Bt; int M, N, K; };

struct StaticOrder {
    int nM, nN, nwg, G, c;
    __host__ __device__ void init(int M, int N, int G_, int c_) { nM = M / BM; nN = N / BM; nwg = nM * nN; G = G_; c = c_; }
    __host__ __device__ bool next(int i, Unit& u) const {
        const long L = (long)i * G + c; if (L >= nwg) return false;
        int wgid = (int)L; { const int q = nwg / NXCD, r = nwg % NXCD, xcd = wgid % NXCD, off = wgid / NXCD; wgid = (xcd < r ? xcd * (q + 1) : r * (q + 1) + (xcd - r) * q) + off; }
        const int nig = WGM * nN, gid = wgid / nig, fm = gid * WGM, gsz = (nM - fm) < WGM ? (nM - fm) : WGM;
        u.pm = fm + ((wgid % nig) % gsz); u.pn = (wgid % nig) / gsz; return true;
    }
    __device__ __forceinline__ void a_ready(const Unit&) const {}
    __device__ __forceinline__ void done(const Unit&) const {}
};

__device__ __forceinline__ unsigned cvt_pk_bf16(float lo, float hi) { unsigned r; asm volatile("v_cvt_pk_bf16_f32 %0, %1, %2" : "=v"(r) : "v"(lo), "v"(hi)); return r; }
__device__ __forceinline__ float sigmoid_f(float x) { return __builtin_amdgcn_rcpf(1.0f + __builtin_amdgcn_exp2f(-1.4426950408889634f * x)); }
__device__ __forceinline__ f32x4 sigmoid4(f32x4 v) { return (f32x4){sigmoid_f(v[0]), sigmoid_f(v[1]), sigmoid_f(v[2]), sigmoid_f(v[3])}; }

struct EpiIn {
    static constexpr bool PERM = true, AFTER_DRAIN = false;
    unsigned char* ws; const float* ss; const float* qg; const float* kg; float qscale;
    __device__ __forceinline__ void operator()(const f32x4 (&acc)[2][2][4][2], const Unit& u, int wr, int wc, int fr, int fq) const {
        const int j = u.pn;
        const int row0 = u.pm * BM + wr * 64 + fr;
        float rs[2][4];
#pragma unroll
        for (int ai = 0; ai < 2; ++ai)
#pragma unroll
            for (int m = 0; m < 4; ++m) rs[ai][m] = 1.0f / sqrtf(ss[row0 + ai * HALF + m * 16] * (1.0f / 1024.0f) + 1e-6f);
        int type, ld, coff; size_t boff;
        if (j < 4) { ld = 256; coff = 0; boff = (size_t)(256 + 32 * j) << 20; type = (j == 0) ? 3 : (j == 1) ? 4 : (j == 2) ? 0 : 1; }
        else if (j < 14) { const int t = (j - 4) >> 1; ld = 512; coff = 256 * ((j - 4) & 1); boff = (size_t)(384 + 64 * t) << 20; type = (t == 3) ? 2 : (t == 4) ? 1 : 0; }
        else if (j < 16) { ld = 256; coff = 128 * (j - 14); boff = (size_t)704 << 20; type = 5; }
        else { ld = 256; coff = 0; boff = (size_t)736 << 20; type = 1; }
        bf16_t* base = (bf16_t*)(ws + boff);
        if (type == 5) {
#pragma unroll
            for (int ai = 0; ai < 2; ++ai)
#pragma unroll
                for (int m = 0; m < 4; ++m) { const float s = rs[ai][m]; bf16_t* p = base + (size_t)(row0 + ai * HALF + m * 16) * ld + coff + 32 * wc + 8 * fq;
                    const f32x4 a0 = acc[ai][0][m][0] * s, a1 = acc[ai][0][m][1] * s, b0 = sigmoid4(acc[ai][1][m][0] * s), b1 = sigmoid4(acc[ai][1][m][1] * s);
                    const f32x4 v0 = a0 * b0, v1 = a1 * b1;
                    u32x4 w; w.x = cvt_pk_bf16(v0[0], v0[1]); w.y = cvt_pk_bf16(v0[2], v0[3]); w.z = cvt_pk_bf16(v1[0], v1[1]); w.w = cvt_pk_bf16(v1[2], v1[3]);
                    *(u32x4*)p = w; }
        } else if (type == 3 || type == 4) {
            const float* gp = (type == 3) ? qg : kg; const float sc = (type == 3) ? qscale : 1.0f;
            f32x4 gv[2][2];
#pragma unroll
            for (int bj = 0; bj < 2; ++bj)
#pragma unroll
                for (int n = 0; n < 2; ++n) gv[bj][n] = *(const f32x4*)(gp + 32 * bj + 8 * fq + 4 * n) * sc;
#pragma unroll
            for (int ai = 0; ai < 2; ++ai)
#pragma unroll
                for (int m = 0; m < 4; ++m) { const float s = rs[ai][m]; bf16_t* p = base + (size_t)(row0 + ai * HALF + m * 16) * ld + coff + 64 * wc + 8 * fq;
                    f32x4 v[2][2]; float q = 0.f;
#pragma unroll
                    for (int bj = 0; bj < 2; ++bj)
#pragma unroll
                        for (int n = 0; n < 2; ++n) { v[bj][n] = acc[ai][bj][m][n] * s; const f32x4 x = v[bj][n]; q += (x[0] * x[0] + x[1] * x[1]) + (x[2] * x[2] + x[3] * x[3]); }
                    q += __shfl_xor(q, 16); q += __shfl_xor(q, 32);
                    const float hr = 1.0f / sqrtf(q * (1.0f / 64.0f) + 1e-6f);
#pragma unroll
                    for (int bj = 0; bj < 2; ++bj) { const f32x4 v0 = v[bj][0] * hr * gv[bj][0], v1 = v[bj][1] * hr * gv[bj][1];
                        u32x4 w; w.x = cvt_pk_bf16(v0[0], v0[1]); w.y = cvt_pk_bf16(v0[2], v0[3]); w.z = cvt_pk_bf16(v1[0], v1[1]); w.w = cvt_pk_bf16(v1[2], v1[3]);
                        *(u32x4*)(p + 32 * bj) = w; } }
        } else {
#pragma unroll
            for (int ai = 0; ai < 2; ++ai)
#pragma unroll
                for (int m = 0; m < 4; ++m) { const float s = rs[ai][m]; bf16_t* p = base + (size_t)(row0 + ai * HALF + m * 16) * ld + coff + 64 * wc + 8 * fq;
#pragma unroll
                    for (int bj = 0; bj < 2; ++bj) { f32x4 v0 = acc[ai][bj][m][0] * s, v1 = acc[ai][bj][m][1] * s;
                        if (type == 1) { v0 = v0 * sigmoid4(v0); v1 = v1 * sigmoid4(v1); }
                        else if (type == 2) { v0 = sigmoid4(v0); v1 = sigmoid4(v1); }
                        u32x4 w; w.x = cvt_pk_bf16(v0[0], v0[1]); w.y = cvt_pk_bf16(v0[2], v0[3]); w.z = cvt_pk_bf16(v1[0], v1[1]); w.w = cvt_pk_bf16(v1[2], v1[3]);
                        *(u32x4*)(p + 32 * bj) = w; } }
        }
    }
};

struct EpiOut {
    static constexpr bool PERM = false, AFTER_DRAIN = false;
    const float* base; float* out; bf16_t* xn; float* ssq;
    __device__ __forceinline__ void operator()(const f32x4 (&acc)[2][2][4][2], const Unit& u, int wr, int wc, int fr, int fq) const {
        typedef unsigned u32x2v __attribute__((ext_vector_type(2)));
        const int row0 = u.pm * BM + wr * 64 + fr, col0 = u.pn * BM + wc * 32 + 4 * fq;
#pragma unroll
        for (int ai = 0; ai < 2; ++ai)
#pragma unroll
            for (int m = 0; m < 4; ++m) { const int r = row0 + ai * HALF + m * 16; const size_t off = (size_t)r * 1024 + col0; float q = 0.f;
#pragma unroll
                for (int bj = 0; bj < 2; ++bj)
#pragma unroll
                    for (int n = 0; n < 2; ++n) { const size_t o2 = off + bj * HALF + n * 16; const f32x4 o = *(const f32x4*)(base + o2) + acc[ai][bj][m][n];
                        *(f32x4*)(out + o2) = o;
                        if (xn) { u32x2v w; w.x = cvt_pk_bf16(o[0], o[1]); w.y = cvt_pk_bf16(o[2], o[3]); *(u32x2v*)(xn + o2) = w; q += (o[0] * o[0] + o[1] * o[1]) + (o[2] * o[2] + o[3] * o[3]); } }
                if (xn) { q += __shfl_xor(q, 16); q += __shfl_xor(q, 32); if (fq == 0) atomicAdd(ssq + r, q); } }
    }
};

template <class Epi, class Sched, bool ALIGN_EPI = false, bool SP2 = false>
__device__ __forceinline__ void gemm_phase(PG8_LAS unsigned char* lds, const Gemm g, const Sched& S, const Epi& E) {
    int tid_ = threadIdx.x; asm volatile("" : "+v"(tid_));
    const int tid = tid_, wid = __builtin_amdgcn_readfirstlane(tid >> 6), lane = tid & 63, wr = wid >> 2, wc = wid & 3, fr = lane & 15, fq = lane >> 4;
    const int K = g.K, nt = K / BK;
    unsigned voffA[2], voffB[2];
#pragma unroll
    for (int i = 0; i < 2; ++i) { int R, C; stage_rc(tid * 16 + i * 8192, R, C); const int Rb = Epi::PERM ? ((R & ~31) + perm32(R & 31)) : R;
        voffA[i] = (unsigned)(R * K + C) * 2u; voffB[i] = (unsigned)(Rb * K + C) * 2u; }
    const size_t kstep = (size_t)(BK * 2);
    const size_t hstep = (size_t)HALF * K * 2;
    const size_t tstep = 2 * hstep;
    const unsigned ldsw = (unsigned)wid * 1024u;
    const int aoff = lds_byte(wr * 64 + fr, fq * 8), boff = lds_byte(wc * 32 + fr, fq * 8);
#define PG8_SA(b, h) (((b) * 2 + (h)) * HTB)
#define PG8_SB(b, h) ((4 + (b) * 2 + (h)) * HTB)
#define PG8_STAGE(bufoff, gbase, voff) do { _Pragma("unroll") for (int _i = 0; _i < 2; ++_i) \
        __builtin_amdgcn_global_load_lds((const unsigned*)((const char*)(gbase) + (voff)[_i]), (PG8_LAS unsigned*)(lds + (bufoff) + ldsw + _i * 8192), 16, 0, 0); } while (0)
#define PG8_LDA(dst, b, h) do { _Pragma("unroll") for (int m = 0; m < 4; ++m) _Pragma("unroll") for (int k = 0; k < 2; ++k) dst[m][k] = *(const PG8_LAS bf16x8*)(lds + PG8_SA(b, h) + aoff + m * 2048 + k * 1024); } while (0)
#define PG8_LDB(dst, b, h) do { _Pragma("unroll") for (int n = 0; n < 2; ++n) _Pragma("unroll") for (int k = 0; k < 2; ++k) dst[n][k] = *(const PG8_LAS bf16x8*)(lds + PG8_SB(b, h) + boff + n * 2048 + k * 1024); } while (0)
#define PG8_MMA(ai, bj, At, Bt) do { __builtin_amdgcn_s_setprio(1); _Pragma("unroll") for (int m = 0; m < 4; ++m) _Pragma("unroll") for (int n = 0; n < 2; ++n) _Pragma("unroll") for (int k = 0; k < 2; ++k) \
        acc[ai][bj][m][n] = __builtin_amdgcn_mfma_f32_16x16x32_bf16(Bt[n][k], At[m][k], acc[ai][bj][m][n], 0, 0, 0); __builtin_amdgcn_s_setprio(0); } while (0)
#define PG8_WAIT_V(n) asm volatile("s_waitcnt vmcnt(" #n ")" ::: "memory")
#define PG8_WAIT_L(n) asm volatile("s_waitcnt lgkmcnt(" #n ")" ::: "memory")
#define PG8_BAR __builtin_amdgcn_s_barrier()
#define PG8_SCHED __builtin_amdgcn_sched_barrier(0)
    Unit cur, nxt; int ui = 0;
    if (!S.next(0, cur)) return;
    f32x4 acc[2][2][4][2];
#pragma unroll
    for (int a = 0; a < 2; ++a)
#pragma unroll
        for (int b = 0; b < 2; ++b)
#pragma unroll
            for (int m = 0; m < 4; ++m)
#pragma unroll
                for (int n = 0; n < 2; ++n) acc[a][b][m][n] = (f32x4){0.f, 0.f, 0.f, 0.f};
    bf16x8 At[4][2], B0[2][2], B1[2][2];
    const char* cA = (const char*)g.A + (size_t)cur.pm * tstep; const char* cB = (const char*)g.Bt + (size_t)cur.pn * tstep;
    S.a_ready(cur);
    if constexpr (SP2) {
        PG8_STAGE(PG8_SB(0, 0), cB, voffB); PG8_STAGE(PG8_SB(0, 1), cB + hstep, voffB); PG8_STAGE(PG8_SA(0, 0), cA, voffA); PG8_STAGE(PG8_SA(0, 1), cA + hstep, voffA);
        if (wr == 1) PG8_BAR;
        PG8_WAIT_V(2); PG8_BAR;
        PG8_STAGE(PG8_SB(1, 0), cB + kstep, voffB); PG8_STAGE(PG8_SA(1, 0), cA + kstep, voffA); PG8_STAGE(PG8_SB(1, 1), cB + hstep + kstep, voffB);
        PG8_WAIT_V(6); PG8_BAR;
    } else {
        PG8_STAGE(PG8_SB(0, 0), cB, voffB); PG8_STAGE(PG8_SA(0, 0), cA, voffA); PG8_STAGE(PG8_SB(0, 1), cB + hstep, voffB); PG8_STAGE(PG8_SA(0, 1), cA + hstep, voffA);
        if (wr == 1) PG8_BAR;
        PG8_WAIT_V(4); PG8_BAR;
        PG8_STAGE(PG8_SB(1, 0), cB + kstep, voffB); PG8_STAGE(PG8_SA(1, 0), cA + kstep, voffA); PG8_STAGE(PG8_SB(1, 1), cB + hstep + kstep, voffB);
        PG8_WAIT_V(6); PG8_BAR;
    }
    for (;;) {
        const bool has_next = S.next(ui + 1, nxt);
        const char* nA = has_next ? (const char*)g.A + (size_t)nxt.pm * tstep : cA; const char* nB = has_next ? (const char*)g.Bt + (size_t)nxt.pn * tstep : cB;
        for (int t = 0; t < nt; t += 2) {
            const bool last = (t == nt - 2);
            const char* a1 = cA + (size_t)(t + 1) * kstep;
            const char* a2 = last ? nA : cA + (size_t)(t + 2) * kstep; const char* b2 = last ? nB : cB + (size_t)(t + 2) * kstep;
            const char* a3 = a2 + kstep; const char* b3 = b2 + kstep;
            if (last && has_next) S.a_ready(nxt);
            if constexpr (SP2) {
            PG8_LDB(B0, 0, 0); PG8_LDB(B1, 0, 1); PG8_SCHED; PG8_LDA(At, 0, 0); PG8_STAGE(PG8_SA(1, 1), a1 + hstep, voffA);
            PG8_WAIT_V(8); PG8_WAIT_L(0); PG8_BAR; PG8_MMA(0, 0, At, B0); PG8_MMA(0, 1, At, B1); PG8_BAR; PG8_SCHED;
            PG8_LDA(At, 0, 1); PG8_STAGE(PG8_SB(0, 0), b2, voffB); PG8_STAGE(PG8_SB(0, 1), b2 + hstep, voffB); PG8_STAGE(PG8_SA(0, 0), a2, voffA);
            PG8_WAIT_V(8); PG8_WAIT_L(0); PG8_BAR; PG8_MMA(1, 0, At, B0); PG8_MMA(1, 1, At, B1); PG8_BAR; PG8_SCHED;
            PG8_LDB(B0, 1, 0); PG8_LDB(B1, 1, 1); PG8_SCHED; PG8_LDA(At, 1, 0); PG8_STAGE(PG8_SA(0, 1), a2 + hstep, voffA);
            PG8_WAIT_V(8); PG8_WAIT_L(0); PG8_BAR; PG8_MMA(0, 0, At, B0); PG8_MMA(0, 1, At, B1); PG8_BAR; PG8_SCHED;
            PG8_LDA(At, 1, 1); PG8_STAGE(PG8_SB(1, 0), b3, voffB); PG8_STAGE(PG8_SB(1, 1), b3 + hstep, voffB); PG8_STAGE(PG8_SA(1, 0), a3, voffA);
            PG8_WAIT_V(8); PG8_WAIT_L(0); PG8_BAR; PG8_MMA(1, 0, At, B0); PG8_MMA(1, 1, At, B1); PG8_BAR; PG8_SCHED;
            } else {
            PG8_LDB(B0, 0, 0); PG8_SCHED; PG8_LDA(At, 0, 0); PG8_STAGE(PG8_SA(1, 1), a1 + hstep, voffA);
            PG8_WAIT_L(8); PG8_BAR; PG8_WAIT_L(0); PG8_MMA(0, 0, At, B0); PG8_BAR; PG8_SCHED;
            PG8_LDB(B1, 0, 1); PG8_STAGE(PG8_SB(0, 0), b2, voffB);
            PG8_BAR; PG8_WAIT_L(0); PG8_MMA(0, 1, At, B1); PG8_BAR;
            PG8_LDA(At, 0, 1); PG8_STAGE(PG8_SA(0, 0), a2, voffA);
            PG8_BAR; PG8_WAIT_L(0); PG8_MMA(1, 0, At, B0); PG8_BAR; PG8_SCHED;
            PG8_STAGE(PG8_SB(0, 1), b2 + hstep, voffB);
            PG8_WAIT_V(6); PG8_BAR; PG8_MMA(1, 1, At, B1); PG8_BAR;
            PG8_LDB(B0, 1, 0); PG8_SCHED; PG8_LDA(At, 1, 0); PG8_STAGE(PG8_SA(0, 1), a2 + hstep, voffA);
            PG8_WAIT_L(8); PG8_BAR; PG8_WAIT_L(0); PG8_MMA(0, 0, At, B0); PG8_BAR; PG8_SCHED;
            PG8_LDB(B1, 1, 1); PG8_STAGE(PG8_SB(1, 0), b3, voffB);
            PG8_BAR; PG8_WAIT_L(0); PG8_MMA(0, 1, At, B1); PG8_BAR;
            PG8_LDA(At, 1, 1); PG8_STAGE(PG8_SA(1, 0), a3, voffA);
            PG8_BAR; PG8_WAIT_L(0); PG8_MMA(1, 0, At, B0); PG8_BAR; PG8_SCHED;
            PG8_STAGE(PG8_SB(1, 1), b3 + hstep, voffB);
            PG8_WAIT_V(6); PG8_BAR; PG8_MMA(1, 1, At, B1); PG8_BAR;
            }
        }
        if constexpr (ALIGN_EPI) { if (wr == 0) PG8_BAR; }
        if constexpr (!Epi::AFTER_DRAIN) { E(acc, cur, wr, wc, fr, fq); S.done(cur); }
        if (!has_next) break;
#pragma unroll
        for (int a = 0; a < 2; ++a)
#pragma unroll
            for (int b = 0; b < 2; ++b)
#pragma unroll
                for (int m = 0; m < 4; ++m)
#pragma unroll
                    for (int n = 0; n < 2; ++n) acc[a][b][m][n] = (f32x4){0.f, 0.f, 0.f, 0.f};
        cur = nxt; cA = nA; cB = nB; ++ui;
        if constexpr (ALIGN_EPI) { if (wr == 1) PG8_BAR; }
    }
    PG8_WAIT_V(0);
    if constexpr (!ALIGN_EPI) { if (wr == 0) PG8_BAR; }
    PG8_BAR;
    if constexpr (Epi::AFTER_DRAIN) { E.fused(acc, cur, wr, wc, fr, fq, lds, wid, lane); S.done(cur); }
#undef PG8_SA
#undef PG8_SB
#undef PG8_STAGE
#undef PG8_LDA
#undef PG8_LDB
#undef PG8_MMA
#undef PG8_WAIT_V
#undef PG8_WAIT_L
#undef PG8_BAR
#undef PG8_SCHED
}
}
#define GAS __attribute__((address_space(1)))
#define LAS __attribute__((address_space(3)))
typedef unsigned short bf16;
typedef unsigned v4u __attribute__((ext_vector_type(4)));
typedef float f32x4 __attribute__((ext_vector_type(4)));
typedef short bf16x8 __attribute__((ext_vector_type(8)));
typedef GAS unsigned gu32;
typedef GAS unsigned long long gu64;
#define RLX_AGENT __ATOMIC_RELAXED, __HIP_MEMORY_SCOPE_AGENT
#define LDS_WAIT() asm volatile("s_waitcnt lgkmcnt(0)" ::: "memory")
#define VM_WAIT() asm volatile("s_waitcnt vmcnt(0)" ::: "memory")
__device__ __forceinline__ unsigned long long rt() { return __builtin_amdgcn_s_memrealtime(); }
__device__ __forceinline__ unsigned f2bf(float f) { unsigned u = __builtin_bit_cast(unsigned, f); return (u + 0x7fffu + ((u >> 16) & 1u)) >> 16; }
__device__ __forceinline__ unsigned pk2(float lo, float hi) { return f2bf(lo) | (f2bf(hi) << 16); }

#define XB_TMO      128
#define XB_XCNT(j)  (256  + 64 * (j))
#define XB_XSUB(j)  (1280 + 64 * (j))
#define XB_XGEN(j)  (2304 + 64 * (j))
#define XB_TOP      3328
#define XB_TOPGEN   3392
#define XCD_BAR_WORDS 3456
#define XB_SPIN_CAP (1u << 18)

__device__ __forceinline__ unsigned xb_ld(unsigned* p)              { return __hip_atomic_load(p, __ATOMIC_RELAXED, __HIP_MEMORY_SCOPE_AGENT); }
__device__ __forceinline__ unsigned xb_add(unsigned* p, unsigned v) { return __hip_atomic_fetch_add(p, v, __ATOMIC_RELAXED, __HIP_MEMORY_SCOPE_AGENT); }
__device__ __forceinline__ unsigned xb_xcc_id() { return (unsigned)__builtin_amdgcn_s_getreg((3 << 11) | 20) & 0xFu; }
#define XB_SPIN(cond, bar) do { unsigned _sp = 0; while (cond) { __builtin_amdgcn_s_sleep(1); \
    if ((++_sp & 255u) == 0u) { if (xb_ld(&(bar)[XB_TMO])) break; if (_sp > XB_SPIN_CAP) { atomicAdd(&(bar)[XB_TMO], 1u); break; } } } } while (0)

struct XcdBarrier {
    unsigned* bar; unsigned x;
    volatile LAS unsigned* st;
};

__device__ __forceinline__ XcdBarrier xcd_barrier_post(unsigned* bar, volatile LAS unsigned* st) {
    XcdBarrier b; b.bar = bar; b.x = xb_xcc_id(); b.st = st;
    if (threadIdx.x == 0) (void)xb_add(&bar[XB_XCNT(b.x)], 1u);
    return b;
}
__device__ __forceinline__ void xcd_barrier_complete(unsigned* bar, unsigned x, unsigned& nloc, unsigned& nx) {
    const unsigned G = gridDim.x * gridDim.y * gridDim.z;
    unsigned sum, cnt, mine, sp = 0u;
    for (;;) {
        sum = 0u; cnt = 0u; mine = 0u;
#pragma unroll
        for (unsigned j = 0; j < 16; ++j) { const unsigned c = xb_ld(&bar[XB_XCNT(j)]); sum += c; cnt += (c > 0u) ? 1u : 0u; mine = (j == x) ? c : mine; }
        if (sum == G) break;
        __builtin_amdgcn_s_sleep(1);
        if ((++sp & 255u) == 0u) { if (xb_ld(&bar[XB_TMO])) break; if (sp > XB_SPIN_CAP) { atomicAdd(&bar[XB_TMO], 1u); break; } }
    }
    nloc = mine > 0u ? mine : 1u; nx = cnt > 0u ? cnt : 1u;
}

__device__ __forceinline__ void xcd_barrier(const XcdBarrier& b) {
    asm volatile("s_waitcnt vmcnt(0)" ::: "memory");
    __syncthreads();
    if (threadIdx.x == 0) {
        unsigned* bar = b.bar;
        __builtin_amdgcn_s_waitcnt(0);
        unsigned nloc = b.st[0], nx = b.st[1];
        if (nloc == 0u) { xcd_barrier_complete(bar, b.x, nloc, nx); b.st[0] = nloc; b.st[1] = nx; }
        const unsigned old = xb_add(&bar[XB_XSUB(b.x)], 1u);
        const unsigned gen = old / nloc;
        if (old + 1u == (gen + 1u) * nloc) {
            __builtin_amdgcn_fence(__ATOMIC_RELEASE, "agent");
            asm volatile("s_waitcnt vmcnt(0)" ::: "memory");
            const unsigned og = xb_add(&bar[XB_TOP], 1u);
            const unsigned tg = og / nx;
            if (og + 1u == (tg + 1u) * nx) xb_add(&bar[XB_TOPGEN], 1u);
            else XB_SPIN(xb_ld(&bar[XB_TOPGEN]) == tg, bar);
            __builtin_amdgcn_fence(__ATOMIC_ACQUIRE, "agent");
            xb_add(&bar[XB_XGEN(b.x)], 1u);
            asm volatile("s_waitcnt vmcnt(0)" ::: "memory");
        } else {
            XB_SPIN(xb_ld(&bar[XB_XGEN(b.x)]) == gen, bar);
            __builtin_amdgcn_fence(__ATOMIC_ACQUIRE, "agent");
            asm volatile("s_waitcnt vmcnt(0)" ::: "memory");
        }
    }
    __syncthreads();
}

constexpr int NWAVES = 8;
constexpr int BATCH = 8, SEQ = 8192, DM = 1024, M = BATCH * SEQ;
constexpr int DIN = 4360, NIN = 4352;
constexpr float EPS = 1e-6f;
#ifndef MK_N_LAUNCHES
#define MK_N_LAUNCHES 13
#endif
constexpr int N_PHASES = 13;
constexpr int N_LAUNCHES = MK_N_LAUNCHES;

constexpr size_t MiB = 1u << 20;
constexpr size_t WS_CTL = 0, CTL_ZERO_BYTES = 1 * MiB;
constexpr size_t WS_SS1 = 512 * 1024;
constexpr size_t WS_WIN = 2 * MiB;
constexpr size_t WIN_BYTES = (size_t)NIN * 1024 * 2;
constexpr size_t WS_WG = 20 * MiB;
constexpr size_t WS_WOUT = 21 * MiB;
constexpr size_t WS_SS0 = 26 * MiB;
constexpr size_t WS_IG = 27 * MiB, WS_LF = 28 * MiB;
constexpr size_t WS_XN = 128 * MiB;
constexpr size_t WS_AQ = 256 * MiB, WS_AK = 288 * MiB, WS_AV = 320 * MiB, WS_AZ = 352 * MiB;
constexpr size_t WS_MQ = 384 * MiB, WS_MK = 448 * MiB, WS_MV = 512 * MiB, WS_MO = 576 * MiB, WS_MZ = 640 * MiB;
constexpr size_t WS_CU = 704 * MiB, WS_CZ = 736 * MiB;
constexpr size_t WS_MIX = 768 * MiB;
constexpr size_t WS_HB = 896 * MiB;
constexpr size_t WS_END = 1024 * MiB;
constexpr int CW_TMO = 0, CW_CODE = 1;
constexpr int CW_BAR = 4096;

constexpr int RING_OFF = 0, RING_BYTES = 131072;
constexpr int LDSCTL_OFF = 139264, MISC_OFF = LDSCTL_OFF + 320;
constexpr int LDS_BYTES = 147456;


struct Frame {
    LAS unsigned char* lds;
    volatile LAS unsigned* MISC;
    gu32* ctl;
    int tid, lane, wave;
    int vcu, G;
    unsigned char* ws;
};
#define IN_X(a) ((a).in[0])
#define IN_NORM_G(a) ((a).in[1])
#define IN_W_IN(a) ((a).in[2])
#define IN_ATT_Q_G(a) ((a).in[3])
#define IN_ATT_K_G(a) ((a).in[4])
#define IN_REL_BIAS(a) ((a).in[5])
#define IN_ML_CONV_W(a) ((a).in[6])
#define IN_ML_CONV_B(a) ((a).in[7])
#define IN_ML_B_I(a) ((a).in[8])
#define IN_ML_B_F(a) ((a).in[9])
#define IN_ML_OUT_G(a) ((a).in[10])
#define IN_CV_DW_W(a) ((a).in[11])
#define IN_CV_DW_B(a) ((a).in[12])
#define IN_CV_LN_G(a) ((a).in[13])
#define IN_CV_LN_B(a) ((a).in[14])
#define IN_W_OUT(a) ((a).in[15])
struct Args { const float* in[16]; float* out; unsigned char* ws; int ph_lo, ph_hi, li, pad; };
__device__ __forceinline__ float bf2f(unsigned short h) { return __uint_as_float((unsigned)h << 16); }
__device__ __forceinline__ float bflo(unsigned w) { return __uint_as_float(w << 16); }
__device__ __forceinline__ float bfhi(unsigned w) { return __uint_as_float(w & 0xffff0000u); }
__device__ __forceinline__ float wave_sum(float v) {
#pragma unroll
    for (int o = 1; o < 64; o <<= 1) v += __shfl_xor(v, o);
    return v;
}
__device__ __forceinline__ float wave_max(float v) {
#pragma unroll
    for (int o = 1; o < 64; o <<= 1) v = fmaxf(v, __shfl_xor(v, o));
    return v;
}
__device__ __forceinline__ float sigm(float x) { return 1.0f / (1.0f + __expf(-x)); }

__device__ __forceinline__ int in_src_col(int j, int g) {
    const int bj = g >> 2, wc = g & 3;
    if (j < 4) return 256 * j + 64 * wc + 32 * bj;
    if (j < 14) return 1024 + 512 * ((j - 4) >> 1) + 256 * ((j - 4) & 1) + 64 * wc + 32 * bj;
    if (j < 16) return (bj == 0 ? 3592 : 3848) + 128 * (j - 14) + 32 * wc;
    return 4104 + 64 * wc + 32 * bj;
}
__device__ __forceinline__ void p0_transpose_item(const float* W, int ldw, int src0, int k0, const float* gain, bf16* WT, int K, int n0, LAS float* scr, int lane) {
#pragma unroll 8
    for (int i = 0; i < 32; ++i) { const int kk = 2 * i + (lane >> 5); float v = W[(size_t)(k0 + kk) * ldw + src0 + (lane & 31)]; if (gain) v *= gain[k0 + kk]; scr[kk * 33 + (lane & 31)] = v; }
    LDS_WAIT(); asm volatile("" ::: "memory");
    const int c = lane & 7;
#pragma unroll
    for (int jj = 0; jj < 4; ++jj) { const int n = (lane >> 3) + 8 * jj; const LAS float* s = scr + (8 * c) * 33 + n;
        v4u o; o.x = pk2(s[0 * 33], s[1 * 33]); o.y = pk2(s[2 * 33], s[3 * 33]); o.z = pk2(s[4 * 33], s[5 * 33]); o.w = pk2(s[6 * 33], s[7 * 33]);
        *(GAS v4u*)(WT + (size_t)(n0 + n) * K + k0 + 8 * c) = o; }
    LDS_WAIT(); asm volatile("" ::: "memory");
}
__device__ __forceinline__ void p0_prologue(Frame& F, const Args& A) {
    LAS float* scr = (LAS float*)(F.lds + RING_OFF + F.wave * 16384);
    const int gw = F.vcu * NWAVES + F.wave, NGW = F.G * NWAVES;
    constexpr int I_IN = 16 * (NIN / 32), I_OUT = 16 * 32, I_L = I_IN + I_OUT;
    for (int it = gw; it < 2 * I_L; it += NGW) {
        const int l = it / I_L; int r = it % I_L;
        if (r < I_IN) { const int kb = r / (NIN / 32), ng = r % (NIN / 32);
            p0_transpose_item(IN_W_IN(A) + (size_t)l * 1024 * DIN, DIN, in_src_col(ng >> 3, ng & 7), 64 * kb, IN_NORM_G(A) + l * 1024, (bf16*)(F.ws + WS_WIN + l * WIN_BYTES), 1024, 32 * ng, scr, F.lane); }
        else { r -= I_IN; const int kb = r / 32, nb = r % 32;
            p0_transpose_item(IN_W_OUT(A) + (size_t)l * 1024 * 1024, 1024, 32 * nb, 64 * kb, nullptr, (bf16*)(F.ws + WS_WOUT + (size_t)l * 2 * MiB), 1024, 32 * nb, scr, F.lane); }
    }
    { float* WG = (float*)(F.ws + WS_WG);
      for (int e = gw * 64 + F.lane; e < 2 * 8 * 1024; e += NGW * 64) { const int l = e >> 13, j = (e >> 10) & 7, k = e & 1023;
          WG[e] = IN_NORM_G(A)[l * 1024 + k] * IN_W_IN(A)[(size_t)l * 1024 * DIN + (size_t)k * DIN + 3584 + j]; } }
    bf16* XN = (bf16*)(F.ws + WS_XN); float* SS0 = (float*)(F.ws + WS_SS0);
    for (int m = gw; m < M; m += NGW) {
        const GAS f32x4* xr = (const GAS f32x4*)(IN_X(A) + (size_t)m * DM) + F.lane;
        f32x4 v[4]; float s2 = 0.f;
#pragma unroll
        for (int j = 0; j < 4; ++j) { v[j] = xr[64 * j]; s2 += (v[j].x * v[j].x + v[j].y * v[j].y) + (v[j].z * v[j].z + v[j].w * v[j].w); }
        s2 = wave_sum(s2);
        GAS unsigned long long* o8 = (GAS unsigned long long*)(XN + (size_t)m * DM) + F.lane;
#pragma unroll
        for (int j = 0; j < 4; ++j) o8[64 * j] = (unsigned long long)pk2(v[j].x, v[j].y) | ((unsigned long long)pk2(v[j].z, v[j].w) << 32);
        if (F.lane == 0) SS0[m] = s2;
    }
}

__device__ __forceinline__ void gates_phase(Frame& F, const Args& A, int l, const float* ss) {
    const int gw = F.vcu * NWAVES + F.wave, NGW = F.G * NWAVES;
    const float* WG = (const float*)(F.ws + WS_WG) + l * 8192;
    const bf16* XN = (const bf16*)(F.ws + WS_XN);
    float* IG = (float*)(F.ws + WS_IG); float* LF = (float*)(F.ws + WS_LF);
    f32x4 w[8][2][2];
#pragma unroll
    for (int j = 0; j < 8; ++j)
#pragma unroll
        for (int hlf = 0; hlf < 2; ++hlf) { w[j][hlf][0] = *(const f32x4*)(WG + j * 1024 + 512 * hlf + 8 * F.lane); w[j][hlf][1] = *(const f32x4*)(WG + j * 1024 + 512 * hlf + 8 * F.lane + 4); }
    const float bi = IN_ML_B_I(A)[l * 4 + (F.lane & 3)], bfv = IN_ML_B_F(A)[l * 4 + (F.lane & 3)];
    for (int m = gw; m < M; m += NGW) {
        const v4u* xp = (const v4u*)(XN + (size_t)m * DM + 8 * F.lane);
        const v4u xa = xp[0], xb = xp[64];
        float xf[2][8];
        xf[0][0] = bflo(xa.x); xf[0][1] = bfhi(xa.x); xf[0][2] = bflo(xa.y); xf[0][3] = bfhi(xa.y); xf[0][4] = bflo(xa.z); xf[0][5] = bfhi(xa.z); xf[0][6] = bflo(xa.w); xf[0][7] = bfhi(xa.w);
        xf[1][0] = bflo(xb.x); xf[1][1] = bfhi(xb.x); xf[1][2] = bflo(xb.y); xf[1][3] = bfhi(xb.y); xf[1][4] = bflo(xb.z); xf[1][5] = bfhi(xb.z); xf[1][6] = bflo(xb.w); xf[1][7] = bfhi(xb.w);
        float d[8];
#pragma unroll
        for (int j = 0; j < 8; ++j) { float s = 0.f;
#pragma unroll
            for (int hlf = 0; hlf < 2; ++hlf)
#pragma unroll
                for (int e = 0; e < 8; ++e) s += xf[hlf][e] * w[j][hlf][e >> 2][e & 3];
            d[j] = wave_sum(s); }
        const float rstd = 1.0f / sqrtf(ss[m] * (1.0f / 1024.0f) + EPS);
        const int h = F.lane & 3;
        const float di = (h == 0) ? d[0] : (h == 1) ? d[1] : (h == 2) ? d[2] : d[3];
        const float df = (h == 0) ? d[4] : (h == 1) ? d[5] : (h == 2) ? d[6] : d[7];
        if (F.lane < 4) { IG[(size_t)m * 4 + h] = di * rstd + bi;
            const float fp = df * rstd + bfv;
            LF[(size_t)m * 4 + h] = fminf(fp, 0.f) - log1pf(__expf(-fabsf(fp))); }
    }
}

__device__ __forceinline__ void attn_v1(Frame& F, const Args& A, int l) {
    int lane_ = F.lane; asm volatile("" : "+v"(lane_)); const int gw = F.vcu * NWAVES + F.wave, NGW = F.G * NWAVES, lane = lane_;
    const bf16* AQ = (const bf16*)(F.ws + WS_AQ); const bf16* AK = (const bf16*)(F.ws + WS_AK); const bf16* AV = (const bf16*)(F.ws + WS_AV); const bf16* AZ = (const bf16*)(F.ws + WS_AZ);
    bf16* MIX = (bf16*)(F.ws + WS_MIX);
    for (int it = gw; it < M * 4; it += NGW) {
        const int m = it >> 2, h = it & 3, b = m >> 13, t = m & 8191, c = t >> 6, i = t & 63;
        const float* bias = IN_REL_BIAS(A) + (l * 4 + h) * 257;
        float q[64];
        { const v4u* qp = (const v4u*)(AQ + (size_t)m * 256 + 64 * h);
#pragma unroll
          for (int cc = 0; cc < 8; ++cc) { const v4u w = qp[cc]; q[8 * cc + 0] = bflo(w.x); q[8 * cc + 1] = bfhi(w.x); q[8 * cc + 2] = bflo(w.y); q[8 * cc + 3] = bfhi(w.y); q[8 * cc + 4] = bflo(w.z); q[8 * cc + 5] = bfhi(w.z); q[8 * cc + 6] = bflo(w.w); q[8 * cc + 7] = bfhi(w.w); } }
        float s[9]; float mx = -3.0e38f;
#pragma unroll
        for (int g = 0; g < 9; ++g) {
            const int cb = c - 8 + g;
            if (cb >= 0) {
                const int row = b * SEQ + 64 * cb + lane;
                const v4u* kp = (const v4u*)(AK + (size_t)row * 256 + 64 * h);
                float dot = 0.f;
#pragma unroll
                for (int cc = 0; cc < 8; ++cc) { const v4u w = kp[cc];
                    dot += q[8 * cc + 0] * bflo(w.x) + q[8 * cc + 1] * bfhi(w.x) + q[8 * cc + 2] * bflo(w.y) + q[8 * cc + 3] * bfhi(w.y)
                         + q[8 * cc + 4] * bflo(w.z) + q[8 * cc + 5] * bfhi(w.z) + q[8 * cc + 6] * bflo(w.w) + q[8 * cc + 7] * bfhi(w.w); }
                int rel = i - (64 * g + lane) + 512; rel = rel < -128 ? -128 : (rel > 128 ? 128 : rel);
                s[g] = dot + bias[rel + 128];
                mx = fmaxf(mx, s[g]);
            } else s[g] = -3.0e38f;
        }
        mx = wave_max(mx);
        float lsum = 0.f;
#pragma unroll
        for (int g = 0; g < 9; ++g) { s[g] = (c - 8 + g >= 0) ? __expf(s[g] - mx) : 0.f; lsum += s[g]; }
        lsum = wave_sum(lsum);
        float o = 0.f;
#pragma unroll
        for (int g = 0; g < 9; ++g) {
            const int cb = c - 8 + g;
            if (cb >= 0) {
                const bf16* vp = AV + (size_t)(b * SEQ + 64 * cb) * 256 + 64 * h + lane;
                for (int jj = 0; jj < 64; ++jj) { const float pj = __shfl(s[g], jj); o += pj * bf2f(vp[(size_t)jj * 256]); }
            }
        }
        const float r = o / lsum * bf2f(AZ[(size_t)m * 256 + 64 * h + lane]);
        MIX[(size_t)m * 1024 + 64 * h + lane] = (bf16)f2bf(r);
    }
}

__device__ __forceinline__ void conv_v1(Frame& F, const Args& A, int l) {
    int lane_ = F.lane; asm volatile("" : "+v"(lane_)); const int gw = F.vcu * NWAVES + F.wave, NGW = F.G * NWAVES, lane = lane_;
    const bf16* CU = (const bf16*)(F.ws + WS_CU); const bf16* CZ = (const bf16*)(F.ws + WS_CZ); bf16* MIX = (bf16*)(F.ws + WS_MIX);
    const float* W = IN_CV_DW_W(A) + l * 31 * 256;
    for (int m = gw; m < M; m += NGW) {
        const int b = m >> 13, t = m & 8191;
        float a[4];
#pragma unroll
        for (int k = 0; k < 4; ++k) a[k] = IN_CV_DW_B(A)[l * 256 + lane + 64 * k];
        for (int j = 0; j < 31; ++j) { const int tt = t - 30 + j;
            if (tt >= 0) { const bf16* up = CU + (size_t)(b * SEQ + tt) * 256 + lane;
#pragma unroll
                for (int k = 0; k < 4; ++k) a[k] += bf2f(up[64 * k]) * W[j * 256 + lane + 64 * k]; } }
        const float mean = wave_sum((a[0] + a[1]) + (a[2] + a[3])) * (1.0f / 256.0f);
        float q = 0.f;
#pragma unroll
        for (int k = 0; k < 4; ++k) { a[k] -= mean; q += a[k] * a[k]; }
        const float rstd = 1.0f / sqrtf(wave_sum(q) * (1.0f / 256.0f) + EPS);
#pragma unroll
        for (int k = 0; k < 4; ++k) { const int ch = lane + 64 * k; float y = a[k] * rstd * IN_CV_LN_G(A)[l * 256 + ch] + IN_CV_LN_B(A)[l * 256 + ch];
            y = y * sigm(y); y *= bf2f(CZ[(size_t)m * 256 + ch]);
            MIX[(size_t)m * 1024 + 768 + ch] = (bf16)f2bf(y); }
    }
}

__device__ __forceinline__ void mlstm_v1(Frame& F, const Args& A, int l) {
    const bf16* MQ = (const bf16*)(F.ws + WS_MQ); const bf16* MK = (const bf16*)(F.ws + WS_MK); const bf16* MV = (const bf16*)(F.ws + WS_MV);
    const float* IG = (const float*)(F.ws + WS_IG); const float* LF = (const float*)(F.ws + WS_LF); float* HB = (float*)(F.ws + WS_HB);
    int tid_ = F.tid; asm volatile("" : "+v"(tid_)); const int vv = tid_ >> 5, kg = tid_ & 31;
    for (int it = blockIdx.x; it < 256; it += F.G) {
        const int b = it >> 5, h = (it >> 3) & 3, vs = it & 7;
        float cwq[4][4], cwk[4][4], cbq[4], cbk[4];
#pragma unroll
        for (int e = 0; e < 4; ++e) { const int ch = 128 * h + 4 * kg + e;
            cbq[e] = IN_ML_CONV_B(A)[l * 1024 + ch]; cbk[e] = IN_ML_CONV_B(A)[l * 1024 + 512 + ch];
#pragma unroll
            for (int j = 0; j < 4; ++j) { cwq[j][e] = IN_ML_CONV_W(A)[l * 4096 + j * 1024 + ch]; cwk[j][e] = IN_ML_CONV_W(A)[l * 4096 + j * 1024 + 512 + ch]; } }
        float pq[3][4], pk[3][4];
#pragma unroll
        for (int j = 0; j < 3; ++j)
#pragma unroll
            for (int e = 0; e < 4; ++e) { pq[j][e] = 0.f; pk[j][e] = 0.f; }
        float C[4] = {0.f, 0.f, 0.f, 0.f}, n[4] = {0.f, 0.f, 0.f, 0.f}, mst = 0.f;
        const size_t rb = (size_t)b * SEQ;
        for (int t0 = 0; t0 < SEQ; t0 += 8) {
            typedef unsigned u32x2v __attribute__((ext_vector_type(2)));
            u32x2v rq[8], rk[8]; unsigned short rv[8]; float rig[8], rlf[8];
#pragma unroll
            for (int s = 0; s < 8; ++s) { const size_t row = rb + t0 + s;
                rq[s] = *(const u32x2v*)(MQ + row * 512 + 128 * h + 4 * kg); rk[s] = *(const u32x2v*)(MK + row * 512 + 128 * h + 4 * kg);
                rv[s] = MV[row * 512 + 128 * h + 16 * vs + vv]; rig[s] = IG[row * 4 + h]; rlf[s] = LF[row * 4 + h]; }
#pragma unroll
            for (int s = 0; s < 8; ++s) {
                float cq[4] = {bflo(rq[s].x), bfhi(rq[s].x), bflo(rq[s].y), bfhi(rq[s].y)}, ck[4] = {bflo(rk[s].x), bfhi(rk[s].x), bflo(rk[s].y), bfhi(rk[s].y)};
                float qv[4], kv[4];
#pragma unroll
                for (int e = 0; e < 4; ++e) {
                    float aq = cbq[e] + pq[0][e] * cwq[0][e] + pq[1][e] * cwq[1][e] + pq[2][e] * cwq[2][e] + cq[e] * cwq[3][e];
                    float ak = cbk[e] + pk[0][e] * cwk[0][e] + pk[1][e] * cwk[1][e] + pk[2][e] * cwk[2][e] + ck[e] * cwk[3][e];
                    qv[e] = aq * sigm(aq); kv[e] = ak * sigm(ak) * 0.08838834764831845f;
                    pq[0][e] = pq[1][e]; pq[1][e] = pq[2][e]; pq[2][e] = cq[e]; pk[0][e] = pk[1][e]; pk[1][e] = pk[2][e]; pk[2][e] = ck[e];
                }
                const float vt = bf2f(rv[s]), ig = rig[s], lf = rlf[s];
                const float mn = fmaxf(lf + mst, ig), fp = __expf(lf + mst - mn), ip = __expf(ig - mn);
                float num = 0.f, den = 0.f;
#pragma unroll
                for (int e = 0; e < 4; ++e) { C[e] = fp * C[e] + ip * vt * kv[e]; n[e] = fp * n[e] + ip * kv[e]; num += C[e] * qv[e]; den += n[e] * qv[e]; }
#pragma unroll
                for (int o = 1; o < 32; o <<= 1) { num += __shfl_xor(num, o); den += __shfl_xor(den, o); }
                mst = mn;
                if (kg == 0) HB[(rb + t0 + s) * 512 + 128 * h + 16 * vs + vv] = num / fmaxf(fabsf(den), __expf(-mn));
            }
        }
    }
}
__device__ __forceinline__ void mlfin_v1(Frame& F, const Args& A, int l) {
    int lane_ = F.lane; asm volatile("" : "+v"(lane_)); const int gw = F.vcu * NWAVES + F.wave, NGW = F.G * NWAVES, lane = lane_;
    const bf16* MO = (const bf16*)(F.ws + WS_MO); const bf16* MZ = (const bf16*)(F.ws + WS_MZ); const float* HB = (const float*)(F.ws + WS_HB); bf16* MIX = (bf16*)(F.ws + WS_MIX);
    for (int it = gw; it < M * 4; it += NGW) {
        const int m = it >> 2, h = it & 3;
        float v[2]; float q = 0.f;
#pragma unroll
        for (int k = 0; k < 2; ++k) { const size_t o = (size_t)m * 512 + 128 * h + lane + 64 * k; v[k] = bf2f(MO[o]) * HB[o]; q += v[k] * v[k]; }
        const float rstd = 1.0f / sqrtf(wave_sum(q) * (1.0f / 128.0f) + EPS);
#pragma unroll
        for (int k = 0; k < 2; ++k) { const int ch = 128 * h + lane + 64 * k;
            const float y = v[k] * rstd * IN_ML_OUT_G(A)[l * 512 + ch] * bf2f(MZ[(size_t)m * 512 + ch]);
            MIX[(size_t)m * 1024 + 256 + ch] = (bf16)f2bf(y); }
    }
}


typedef float f32x16 __attribute__((ext_vector_type(16)));
typedef unsigned u32x4 __attribute__((ext_vector_type(4)));
typedef short s16x4 __attribute__((ext_vector_type(4)));
typedef short v4i16_t __attribute__((ext_vector_type(4)));
typedef float f32x2_t __attribute__((ext_vector_type(2))); typedef __bf16 bf16x2_t __attribute__((ext_vector_type(2)));
typedef LAS const unsigned char* lds_cptr;
__device__ __forceinline__ int crow(int r, int hi) { return (r & 3) + 8 * (r >> 2) + 4 * hi; }
__device__ __forceinline__ unsigned cvtpk(float lo, float hi) { f32x2_t v = {lo, hi}; bf16x2_t b = __builtin_convertvector(v, bf16x2_t); return __builtin_bit_cast(unsigned, b); }
__device__ __forceinline__ s16x4 vtr(lds_cptr p) { return __builtin_bit_cast(s16x4, __builtin_amdgcn_ds_read_tr16_b64_v4i16((LAS v4i16_t*)p)); }
__device__ __forceinline__ bf16x8 mk8(s16x4 lo, s16x4 hi) { return (bf16x8){lo[0], lo[1], lo[2], lo[3], hi[0], hi[1], hi[2], hi[3]}; }
#define MFMA32(a, b, c) __builtin_amdgcn_mfma_f32_32x32x16_bf16((a), (b), (c), 0, 0, 0)

constexpr int AT_KSTR = 1040, AT_KHEAD = 8 * AT_KSTR, AT_KBUF = 4 * AT_KHEAD, AT_VHEAD = 8192, AT_VBUF = 4 * AT_VHEAD;
constexpr int AT_K0 = 0, AT_V0 = 2 * AT_KBUF, AT_END = AT_V0 + 2 * AT_VBUF;
constexpr int AT_TAB = AT_END, AT_TABH = 260, AT_WS = AT_TAB + 4 * AT_TABH * 4;
constexpr int AT_LDS_END = AT_WS + 8 * 256;
__device__ __forceinline__ void attn_phase(Frame& F, const Args& A, int l) {
    int tid_ = F.tid; asm volatile("" : "+v"(tid_));
    const int tid = tid_, lane = tid & 63, r32 = lane & 31, hi = lane >> 5, w = F.wave, hh = w >> 1, qh = w & 1;
    const bf16* AQ = (const bf16*)(F.ws + WS_AQ); const bf16* AK = (const bf16*)(F.ws + WS_AK); const bf16* AV = (const bf16*)(F.ws + WS_AV); const bf16* AZ = (const bf16*)(F.ws + WS_AZ);
    bf16* MIX = (bf16*)(F.ws + WS_MIX);
    LAS unsigned char* L = F.lds;
    LAS float* tab = (LAS float*)(L + AT_TAB);
    LAS float* wsf = (LAS float*)(L + AT_WS) + w * 64;
    {
        const float gq = fabsf(IN_ATT_Q_G(A)[l * 64 + lane]), gk = fabsf(IN_ATT_K_G(A)[l * 64 + lane]);
        const float mq = wave_max(gq), mk = wave_max(gk);
        const float* bsrc = IN_REL_BIAS(A) + (l * 4 + (w & 3)) * 257;
        float bm = 0.f;
        for (int i = lane; i < 257; i += 64) bm = fmaxf(bm, fabsf(bsrc[i]));
        bm = wave_max(bm);
        const float mb = 8.2f * mq * mk + bm;
        if (w < 4) for (int i = lane; i < 257; i += 64) tab[w * AT_TABH + i] = (bsrc[i] - mb) * 1.4426950408889634f;
    }
    __syncthreads();
    const int piece = tid & 31, krow = tid >> 5, ph = piece >> 3, pc = piece & 7;
    const int kdst = ph * AT_KHEAD + pc * AT_KSTR + krow * 16;
    const int vdst = ph * AT_VHEAD + (pc >> 2) * 4096 + (krow >> 4) * 1024 + (krow & 15) * 64 + (pc & 3) * 16;
    const int kfrag = hh * AT_KHEAD + hi * AT_KSTR + r32 * 16;
    const int vfrag = hh * AT_VHEAD + ((lane >> 4) & 1) * 32 + (lane & 3) * 8 + (4 * hi + ((lane & 15) >> 2)) * 64;
    const int gw_unit0 = F.vcu * 4;
    for (int ui = 0; ui < 4; ++ui) {
        int u = gw_unit0 + ui; if (F.G != 256) { u = F.vcu + ui * F.G; }
        if (u >= 1024) break;
        const int b = u >> 7, c = u & 127, j0 = (c >= 8) ? c - 8 : 0, nst = c - j0 + 1;
        const size_t rowq = (size_t)b * SEQ + 64 * c;
        u32x4 kst[4], vst[4];
        { const size_t rb = ((size_t)b * SEQ + 64 * j0 + krow) * 256 + piece * 8;
#pragma unroll
          for (int i = 0; i < 4; ++i) { kst[i] = *(const u32x4*)(AK + rb + (size_t)i * 16 * 256); vst[i] = *(const u32x4*)(AV + rb + (size_t)i * 16 * 256); } }
        bf16x8 qf[4];
#pragma unroll
        for (int s = 0; s < 4; ++s) qf[s] = *(const bf16x8*)(AQ + (rowq + 32 * qh + r32) * 256 + 64 * hh + 16 * s + 8 * hi);
#pragma unroll
        for (int i = 0; i < 4; ++i) { *(LAS u32x4*)(L + AT_K0 + kdst + i * 256) = kst[i]; *(LAS u32x4*)(L + AT_V0 + vdst + i * 1024) = vst[i]; }
        __syncthreads();
        f32x16 o0 = {}, o1 = {}; float lsum = 0.f;
        for (int st = 0; st < nst; ++st) {
            const int j = j0 + st, buf = st & 1, dl = c - j;
            const bool more = (st + 1 < nst);
            if (more) { const size_t rb = ((size_t)b * SEQ + 64 * (j + 1) + krow) * 256 + piece * 8;
#pragma unroll
                for (int i = 0; i < 4; ++i) { kst[i] = *(const u32x4*)(AK + rb + (size_t)i * 16 * 256); vst[i] = *(const u32x4*)(AV + rb + (size_t)i * 16 * 256); } }
            const lds_cptr kb = (lds_cptr)(L + AT_K0 + buf * AT_KBUF + kfrag);
            const lds_cptr vb = (lds_cptr)(L + AT_V0 + buf * AT_VBUF + vfrag);
            const float cst = (dl >= 3) ? tab[hh * AT_TABH + 256] : 0.f;
            f32x16 p0, p1;
#pragma unroll
            for (int r = 0; r < 16; ++r) { p0[r] = cst; p1[r] = cst; }
#pragma unroll
            for (int s = 0; s < 4; ++s) {
                const bf16x8 k0 = *(const LAS bf16x8*)(kb + s * 2 * AT_KSTR), k1 = *(const LAS bf16x8*)(kb + s * 2 * AT_KSTR + 512);
                p0 = MFMA32(k0, qf[s], p0); p1 = MFMA32(k1, qf[s], p1);
            }
            if (dl < 3) {
                const int base = 64 * dl + 32 * qh + r32 + 128 - 4 * hi;
#pragma unroll
                for (int r = 0; r < 16; ++r) { const int ik = (r & 3) + 8 * (r >> 2);
                    int i0 = base - ik; i0 = i0 > 256 ? 256 : i0; int i1 = base - ik - 32; i1 = i1 > 256 ? 256 : i1;
                    p0[r] += tab[hh * AT_TABH + i0]; p1[r] += tab[hh * AT_TABH + i1]; }
            }
            float sacc = 0.f;
#pragma unroll
            for (int r = 0; r < 16; ++r) { p0[r] = __builtin_amdgcn_exp2f(p0[r]); p1[r] = __builtin_amdgcn_exp2f(p1[r]); sacc += p0[r] + p1[r]; }
            lsum += sacc;
            u32x4 pw[4];
#pragma unroll
            for (int e = 0; e < 4; ++e) { pw[0][e] = cvtpk(p0[2 * e], p0[2 * e + 1]); pw[1][e] = cvtpk(p0[8 + 2 * e], p0[8 + 2 * e + 1]); pw[2][e] = cvtpk(p1[2 * e], p1[2 * e + 1]); pw[3][e] = cvtpk(p1[8 + 2 * e], p1[8 + 2 * e + 1]); }
#pragma unroll
            for (int kg = 0; kg < 4; ++kg) {
                const bf16x8 pa = __builtin_bit_cast(bf16x8, pw[kg]);
                const bf16x8 v0 = mk8(vtr(vb + kg * 1024), vtr(vb + kg * 1024 + 512));
                const bf16x8 v1 = mk8(vtr(vb + 4096 + kg * 1024), vtr(vb + 4096 + kg * 1024 + 512));
                o0 = MFMA32(pa, v0, o0); o1 = MFMA32(pa, v1, o1);
            }
            if (more) {
#pragma unroll
                for (int i = 0; i < 4; ++i) { *(LAS u32x4*)(L + AT_K0 + (buf ^ 1) * AT_KBUF + kdst + i * 256) = kst[i]; *(LAS u32x4*)(L + AT_V0 + (buf ^ 1) * AT_VBUF + vdst + i * 1024) = vst[i]; }
            }
            __syncthreads();
        }
        lsum += __shfl_xor(lsum, 32);
        if (hi == 0) wsf[r32] = 1.0f / lsum;
        asm volatile("s_waitcnt lgkmcnt(0)" ::: "memory");
        const size_t orow = rowq + 32 * qh;
#pragma unroll
        for (int r = 0; r < 16; ++r) { const int q = crow(r, hi); const float inv = wsf[q];
            const size_t gi = (orow + q) * 256 + 64 * hh + r32, mi = (orow + q) * 1024 + 64 * hh + r32;
            const float y0 = o0[r] * inv * bf2f(AZ[gi]), y1 = o1[r] * inv * bf2f(AZ[gi + 32]);
            MIX[mi] = (bf16)f2bf(y0); MIX[mi + 32] = (bf16)f2bf(y1); }
        asm volatile("s_waitcnt lgkmcnt(0)" ::: "memory");
    }
    __syncthreads();
}


#ifndef MLSTM_G
#define MLSTM_G 8
#endif
constexpr int MG = MLSTM_G, MNT = 64 * MG, MNSC = SEQ / MNT, MUNITS = BATCH * 4 * MNSC;
static_assert(MG == 4 || MG == 8, "super-chunk = 4 or 8 chunks");
constexpr size_t WS_UB = 32 * MiB;
constexpr size_t WS_CS = 96 * MiB;
constexpr size_t WS_NB = 29 * MiB, WS_NS = 30 * MiB;
constexpr size_t WS_KC = 128 * MiB, WS_QC = 192 * MiB;
constexpr size_t WS_SB = 31 * MiB, WS_MS = 31 * MiB + 65536;
constexpr float LOG2E = 1.4426950408889634f;
template <class T> __device__ __forceinline__ T opq(T p) { asm volatile("" : "+v"(p)); return p; }
constexpr int ML_KSTR = 1040, ML_KBSZ = 16 * ML_KSTR;
constexpr int ML_KB = 0, ML_VB = 2 * ML_KBSZ, ML_CB = ML_VB + 2 * 16384, ML_GT = ML_CB + 128 * 272, ML_NS = ML_GT + 3 * MNT * 4, ML_CW = ML_NS + 512, ML_SC = ML_CW + 5120, ML_NA = ML_SC + 64, ML_WS = ML_NA + 512, ML_END = ML_WS + 2048;
static_assert(ML_END <= LDSCTL_OFF, "mLSTM LDS map");

__device__ __forceinline__ void gate_scan(LAS unsigned char* L, const float* LF, const float* IG, size_t R0, int h, float m_start, bool use_ms, int w, int lane, float& A_tot, float& gmax) {
    LAS float* scr = opq((LAS float*)(L + ML_SC)); LAS float* gt = opq((LAS float*)(L + ML_GT));
    float lf = 0.f, ig = 0.f;
    if (w < MG) { lf = LF[(R0 + 64 * w + lane) * 4 + h]; ig = IG[(R0 + 64 * w + lane) * 4 + h]; }
    float x = lf;
#pragma unroll
    for (int o = 1; o < 64; o <<= 1) { const float y = __shfl_up(x, o); if (lane >= o) x += y; }
    if (w < MG && lane == 63) scr[w] = x;
    __syncthreads();
    float off = 0.f, tot = 0.f;
#pragma unroll
    for (int i = 0; i < MG; ++i) { const float v = scr[i]; tot += v; if (i < w) off += v; }
    const float Bp = x + off, g = ig - Bp;
    float pm = g;
#pragma unroll
    for (int o = 1; o < 64; o <<= 1) { const float y = __shfl_up(pm, o); if (lane >= o) pm = fmaxf(pm, y); }
    if (w < MG && lane == 63) scr[8 + w] = pm;
    __syncthreads();
    float pmo = -3.0e38f, gm = -3.0e38f;
#pragma unroll
    for (int i = 0; i < MG; ++i) { const float v = scr[8 + i]; gm = fmaxf(gm, v); if (i < w) pmo = fmaxf(pmo, v); }
    pm = fmaxf(pm, pmo); if (use_ms) pm = fmaxf(pm, m_start);
    if (w < MG) { gt[64 * w + lane] = Bp * LOG2E; gt[MNT + 64 * w + lane] = g * LOG2E; gt[2 * MNT + 64 * w + lane] = pm * LOG2E; }
    A_tot = tot; gmax = gm;
    __syncthreads();
}
__device__ __forceinline__ void unpack8(u32x4 w, float* f) { f[0] = bflo(w.x); f[1] = bfhi(w.x); f[2] = bflo(w.y); f[3] = bfhi(w.y); f[4] = bflo(w.z); f[5] = bfhi(w.z); f[6] = bflo(w.w); f[7] = bfhi(w.w); }
__device__ __forceinline__ u32x4 pack8(const float* f) { u32x4 w; w.x = cvtpk(f[0], f[1]); w.y = cvtpk(f[2], f[3]); w.z = cvtpk(f[4], f[5]); w.w = cvtpk(f[6], f[7]); return w; }
__device__ __forceinline__ float silu_f(float a) { return a * __builtin_amdgcn_rcpf(1.0f + __builtin_amdgcn_exp2f(-LOG2E * a)); }
__device__ __forceinline__ void load_conv_tab(LAS unsigned char* L, const Args& A, int l, int h, int tid) {
    LAS float* cw = opq((LAS float*)(L + ML_CW));
    if (tid < 128) {
#pragma unroll
        for (int tap = 0; tap < 4; ++tap) { cw[tap * 128 + tid] = IN_ML_CONV_W(A)[l * 4096 + tap * 1024 + 128 * h + tid]; cw[640 + tap * 128 + tid] = IN_ML_CONV_W(A)[l * 4096 + tap * 1024 + 512 + 128 * h + tid]; }
        cw[512 + tid] = IN_ML_CONV_B(A)[l * 1024 + 128 * h + tid]; cw[1152 + tid] = IN_ML_CONV_B(A)[l * 1024 + 512 + 128 * h + tid];
    }
}
__device__ __forceinline__ void conv8(const u32x4 (&raw)[4], const LAS float* wt, const LAS float* bt, int col0, float* out) {
    const f32x4 b0 = *(const LAS f32x4*)(bt + col0), b1 = *(const LAS f32x4*)(bt + col0 + 4);
    float a[8] = {b0[0], b0[1], b0[2], b0[3], b1[0], b1[1], b1[2], b1[3]};
#pragma unroll
    for (int tap = 0; tap < 4; ++tap) { float x[8]; unpack8(raw[tap], x);
        const f32x4 w0 = *(const LAS f32x4*)(wt + tap * 128 + col0), w1 = *(const LAS f32x4*)(wt + tap * 128 + col0 + 4);
        a[0] += x[0] * w0[0]; a[1] += x[1] * w0[1]; a[2] += x[2] * w0[2]; a[3] += x[3] * w0[3]; a[4] += x[4] * w1[0]; a[5] += x[5] * w1[1]; a[6] += x[6] * w1[2]; a[7] += x[7] * w1[3]; }
#pragma unroll
    for (int e = 0; e < 8; ++e) out[e] = silu_f(a[e]);
}
__device__ __forceinline__ void load_raw4_fast(const char* base, unsigned off3, u32x4 (&raw)[4]) {
    const char* p = base + (size_t)off3;
#pragma unroll
    for (int tap = 0; tap < 4; ++tap) raw[tap] = *(const u32x4*)(p + tap * 1024);
}
__device__ __forceinline__ void load_raw4_edge(const char* base, unsigned off, int tpos, u32x4 (&raw)[4]) {
#pragma unroll
    for (int tap = 0; tap < 4; ++tap) { const bool ok = (tpos - 3 + tap) >= 0; const unsigned o = ok ? off - (unsigned)(3 - tap) * 1024u : off;
        const u32x4 v = *(const u32x4*)(base + (size_t)o); raw[tap] = ok ? v : (u32x4){0u, 0u, 0u, 0u}; }
}

__device__ __forceinline__ void ml_b1(Frame& F, const Args& A, int l) {
    int tid_ = F.tid; asm volatile("" : "+v"(tid_));
    const int tid = tid_, lane = tid & 63, r32 = lane & 31, hi = lane >> 5, w = F.wave;
    const bf16* MQ = (const bf16*)(F.ws + WS_MQ); const bf16* MK = (const bf16*)(F.ws + WS_MK); const bf16* MV = (const bf16*)(F.ws + WS_MV);
    bf16* KC = (bf16*)(F.ws + WS_KC); bf16* QC = (bf16*)(F.ws + WS_QC);
    const float* LF = (const float*)(F.ws + WS_LF); const float* IG = (const float*)(F.ws + WS_IG);
    float* UB = (float*)(F.ws + WS_UB); float* NB = (float*)(F.ws + WS_NB); float* SB = (float*)(F.ws + WS_SB);
    LAS unsigned char* L = F.lds; LAS float* gt = opq((LAS float*)(L + ML_GT)); LAS float* cw = opq((LAS float*)(L + ML_CW)); LAS float* nacc = opq((LAS float*)(L + ML_NA));
    const int cseg = tid & 15, krow = tid >> 4;
    const int sdst = (cseg >> 2) * 4096 + (krow >> 4) * 1024 + (krow & 15) * 64 + (cseg & 3) * 16;
    const int trl = ((lane >> 4) & 1) * 32 + (lane & 3) * 8 + (4 * hi + ((lane & 15) >> 2)) * 64;
    const int dvt = w >> 1, dkt0 = 2 * (w & 1);
    for (int unit = F.vcu; unit < MUNITS; unit += F.G) {
        const int b = unit / (4 * MNSC), h = (unit / MNSC) & 3, sc = unit % MNSC;
        const size_t R0 = (size_t)b * SEQ + (size_t)sc * MNT;
        load_conv_tab(L, A, l, h, tid);
        if (tid < 128) nacc[tid] = 0.f;
        float A_tot, gmax;
        gate_scan(L, LF, IG, R0, h, 0.f, false, w, lane, A_tot, gmax);
        const float gm2 = gmax * LOG2E;
        f32x16 acc0 = {}, acc1 = {}; float nsum[8] = {0.f, 0.f, 0.f, 0.f, 0.f, 0.f, 0.f, 0.f};
        u32x4 rk[2][4], rq[2][4], rv[2];
        const unsigned koff0 = (unsigned)(((R0 + krow) * 512 + 128 * h + 8 * cseg) * 2);
#define B1_LOAD(j) do { const unsigned ob = opq(koff0 + (unsigned)(j) * 65536u); \
            if (sc == 0 && (j) == 0 && w == 0) { load_raw4_edge((const char*)MK, ob, krow, rk[0]); load_raw4_edge((const char*)MQ, ob, krow, rq[0]); } \
            else { load_raw4_fast((const char*)MK, ob - 3072u, rk[0]); load_raw4_fast((const char*)MQ, ob - 3072u, rq[0]); } \
            load_raw4_fast((const char*)MK, ob + 32768u - 3072u, rk[1]); load_raw4_fast((const char*)MQ, ob + 32768u - 3072u, rq[1]); \
            rv[0] = *(const u32x4*)((const char*)MV + (size_t)ob); rv[1] = *(const u32x4*)((const char*)MV + (size_t)ob + 32768); } while (0)
#define B1_WRITE(j, buf) do { _Pragma("unroll") for (int i = 0; i < 2; ++i) { const int t = 64 * (j) + krow + 32 * i; \
            float kf[8], vf[8]; conv8(rk[i], cw + 640, cw + 1152, 8 * cseg, kf); const float wk = __builtin_amdgcn_exp2f(gt[MNT + t] - gm2); unpack8(rv[i], vf); \
            _Pragma("unroll") for (int e = 0; e < 8; ++e) { kf[e] *= 0.08838834764831845f; nsum[e] += wk * kf[e]; vf[e] *= wk; } \
            const u32x4 kpk = pack8(kf); const size_t go = (size_t)opq(koff0 + (unsigned)(j) * 65536u + (unsigned)i * 32768u); \
            *(LAS u32x4*)(L + ML_KB + (buf) * ML_KBSZ + sdst + i * 2048) = kpk; *(LAS u32x4*)(L + ML_VB + (buf) * 16384 + sdst + i * 2048) = pack8(vf); \
            *(u32x4*)((char*)KC + go) = kpk; conv8(rq[i], cw, cw + 512, 8 * cseg, kf); *(u32x4*)((char*)QC + go) = pack8(kf); } } while (0)
        B1_LOAD(0); B1_WRITE(0, 0);
        __syncthreads();
        for (int j = 0; j < MG; ++j) {
            const int buf = j & 1; const bool more = (j + 1 < MG);
            if (more) B1_LOAD(j + 1);
            const lds_cptr ab = opq((lds_cptr)(L + ML_VB + buf * 16384 + dvt * 4096 + trl));
            const lds_cptr bb = opq((lds_cptr)(L + ML_KB + buf * ML_KBSZ + dkt0 * 4096 + trl));
#pragma unroll
            for (int kg = 0; kg < 4; ++kg) {
                const bf16x8 af = mk8(vtr(ab + kg * 1024), vtr(ab + kg * 1024 + 512));
                const bf16x8 b0 = mk8(vtr(bb + kg * 1024), vtr(bb + kg * 1024 + 512));
                const bf16x8 b1 = mk8(vtr(bb + 4096 + kg * 1024), vtr(bb + 4096 + kg * 1024 + 512));
                acc0 = MFMA32(af, b0, acc0); acc1 = MFMA32(af, b1, acc1);
            }
            if (more) B1_WRITE(j + 1, buf ^ 1);
            __syncthreads();
        }
#undef B1_LOAD
#undef B1_WRITE
        float* U = UB + (size_t)unit * 16384;
#pragma unroll
        for (int r = 0; r < 16; ++r) { const int dv = 32 * dvt + crow(r, hi); U[dv * 128 + 32 * dkt0 + r32] = acc0[r]; U[dv * 128 + 32 * dkt0 + 32 + r32] = acc1[r]; }
#pragma unroll
        for (int e = 0; e < 8; ++e) { float v = nsum[e]; v += __shfl_xor(v, 16); v += __shfl_xor(v, 32); if (lane < 16) __hip_atomic_fetch_add(nacc + 8 * cseg + e, v, __ATOMIC_RELAXED, __HIP_MEMORY_SCOPE_WORKGROUP); }
        __syncthreads();
        if (tid < 128) NB[(size_t)unit * 128 + tid] = nacc[tid];
        if (tid == 0) { SB[unit * 2] = A_tot; SB[unit * 2 + 1] = A_tot + gmax; }
        __syncthreads();
    }
}

__device__ __forceinline__ void ml_b2(Frame& F) {
    int tid_ = F.tid; asm volatile("" : "+v"(tid_));
    const int tid = tid_;
    const float* UB = (const float*)(F.ws + WS_UB); const float* NB = (const float*)(F.ws + WS_NB); const float* SB = (const float*)(F.ws + WS_SB);
    bf16* CS = (bf16*)(F.ws + WS_CS); float* NS = (float*)(F.ws + WS_NS); float* MS = (float*)(F.ws + WS_MS);
    typedef unsigned u32x2v __attribute__((ext_vector_type(2)));
    for (int it = F.vcu; it < 256; it += F.G) {
        const int bh = it >> 3, slice = it & 7; const int e0 = slice * 2048 + tid * 4;
        const bool nown = (slice == 0 && tid < 32);
        f32x4 C = {0.f, 0.f, 0.f, 0.f}, n = {0.f, 0.f, 0.f, 0.f}; float m = 0.f;
#pragma unroll 4
        for (int sc = 0; sc < MNSC; ++sc) {
            const int unit = bh * MNSC + sc;
            u32x2v cw2; cw2.x = cvtpk(C[0], C[1]); cw2.y = cvtpk(C[2], C[3]);
            *(u32x2v*)(CS + (size_t)unit * 16384 + e0) = cw2;
            if (nown) *(f32x4*)(NS + (size_t)unit * 128 + 4 * tid) = n;
            if (slice == 0 && tid == 0) MS[unit] = m;
            const float At = SB[unit * 2], mu = SB[unit * 2 + 1];
            const float mn = fmaxf(At + m, mu), a = __expf(At + m - mn), bb = __expf(mu - mn);
            const f32x4 U4 = *(const f32x4*)(UB + (size_t)unit * 16384 + e0);
            C = C * a + U4 * bb;
            if (nown) { const f32x4 n4 = *(const f32x4*)(NB + (size_t)unit * 128 + 4 * tid); n = n * a + n4 * bb; }
            m = mn;
        }
    }
}

__device__ __forceinline__ void ml_b3(Frame& F, const Args& A, int l) {
    int tid_ = F.tid; asm volatile("" : "+v"(tid_));
    const int tid = tid_, lane = tid & 63, r32 = lane & 31, hi = lane >> 5, w = F.wave;
    const bf16* QC = (const bf16*)(F.ws + WS_QC); const bf16* KC = (const bf16*)(F.ws + WS_KC); const bf16* MV = (const bf16*)(F.ws + WS_MV);
    const float* LF = (const float*)(F.ws + WS_LF); const float* IG = (const float*)(F.ws + WS_IG);
    const bf16* CS = (const bf16*)(F.ws + WS_CS); const float* NS = (const float*)(F.ws + WS_NS); const float* MS = (const float*)(F.ws + WS_MS);
    float* HB = (float*)(F.ws + WS_HB);
    LAS unsigned char* L = F.lds; LAS float* gt = opq((LAS float*)(L + ML_GT)); LAS float* cw = opq((LAS float*)(L + ML_CW)); LAS float* nsl = opq((LAS float*)(L + ML_NS));
    LAS float* wsf = opq((LAS float*)(L + ML_WS) + w * 64);
    const int cseg = tid & 15, krow = tid >> 4;
    const int kdst = cseg * ML_KSTR + krow * 16;
    const int vdst = (cseg >> 2) * 4096 + (krow >> 4) * 1024 + (krow & 15) * 64 + (cseg & 3) * 16;
    const int trl = ((lane >> 4) & 1) * 32 + (lane & 3) * 8 + (4 * hi + ((lane & 15) >> 2)) * 64;
    const int kfrag = hi * ML_KSTR + r32 * 16;
    const int qh = w & 1;
    for (int unit = F.vcu; unit < MUNITS; unit += F.G) {
        const int b = unit / (4 * MNSC), h = (unit / MNSC) & 3, sc = unit % MNSC;
        const size_t R0 = (size_t)b * SEQ + (size_t)sc * MNT;
        const float m_start = MS[unit], ms2 = m_start * LOG2E;
        if (tid < 128) nsl[tid] = NS[(size_t)unit * 128 + tid];
#pragma unroll
        for (int i = 0; i < 4; ++i) { const int p = tid + 512 * i; *(LAS u32x4*)(L + ML_CB + (p >> 4) * 272 + (p & 15) * 16) = *(const u32x4*)(CS + (size_t)unit * 16384 + (size_t)p * 8); }
        float A_tot, gmax;
        gate_scan(L, LF, IG, R0, h, m_start, true, w, lane, A_tot, gmax);
        u32x4 rk[2], rv[2];
        const unsigned koff0 = (unsigned)(((R0 + krow) * 512 + 128 * h + 8 * cseg) * 2);
#define B3_LOAD(j) do { const size_t ob = (size_t)opq(koff0 + (unsigned)(j) * 65536u); \
            rk[0] = *(const u32x4*)((const char*)KC + ob); rk[1] = *(const u32x4*)((const char*)KC + ob + 32768); \
            rv[0] = *(const u32x4*)((const char*)MV + ob); rv[1] = *(const u32x4*)((const char*)MV + ob + 32768); } while (0)
#define B3_WRITE(buf) do { _Pragma("unroll") for (int i = 0; i < 2; ++i) { \
            *(LAS u32x4*)(L + ML_KB + (buf) * ML_KBSZ + kdst + i * 512) = rk[i]; *(LAS u32x4*)(L + ML_VB + (buf) * 16384 + vdst + i * 2048) = rv[i]; } } while (0)
#pragma unroll 1
        for (int pass = 0; pass < MG / 4; ++pass) {
            const int c = (pass == 0) ? (w >> 1) : (MG - 1 - (w >> 1)), jmax = (pass == 0) ? 3 : (MG - 1);
            const int tq = 64 * c + 32 * qh + r32;
            B3_LOAD(0); B3_WRITE(0);
            bf16x8 qf[8]; float dn = 0.f;
            f32x16 o0 = {}, o1 = {}, o2 = {}, o3 = {};
            const lds_cptr cb0 = opq((lds_cptr)(L + ML_CB + r32 * 272 + 16 * hi));
            const float Mq = gt[2 * MNT + tq], wint = __builtin_amdgcn_exp2f(ms2 - Mq);
            const unsigned qoff = opq((unsigned)(((R0 + tq) * 512 + 128 * h + 8 * hi) * 2));
#pragma unroll
            for (int s = 0; s < 8; ++s) {
                qf[s] = *(const bf16x8*)((const char*)QC + (size_t)qoff + 32 * s);
                float q[8]; unpack8(__builtin_bit_cast(u32x4, qf[s]), q);
                const f32x4 n0 = *(const LAS f32x4*)(nsl + 16 * s + 8 * hi), n1 = *(const LAS f32x4*)(nsl + 16 * s + 8 * hi + 4);
                dn += (q[0] * n0[0] + q[1] * n0[1]) + (q[2] * n0[2] + q[3] * n0[3]) + (q[4] * n1[0] + q[5] * n1[1]) + (q[6] * n1[2] + q[7] * n1[3]);
                float qs[8];
#pragma unroll
                for (int e = 0; e < 8; ++e) qs[e] = q[e] * wint;
                const bf16x8 qw = __builtin_bit_cast(bf16x8, pack8(qs));
                const lds_cptr cb = cb0 + 32 * s;
                o0 = MFMA32(qw, *(const LAS bf16x8*)(cb), o0); o1 = MFMA32(qw, *(const LAS bf16x8*)(cb + 32 * 272), o1);
                o2 = MFMA32(qw, *(const LAS bf16x8*)(cb + 64 * 272), o2); o3 = MFMA32(qw, *(const LAS bf16x8*)(cb + 96 * 272), o3);
                if (s & 1) __builtin_amdgcn_sched_barrier(0);
            }
            dn += __shfl_xor(dn, 32);
            float den = 0.f;
            __syncthreads();
            for (int j = 0; j <= jmax; ++j) {
                const int buf = j & 1; const bool more = (j < jmax);
                u32x4 pw[4];
                if (j <= c) {
                    const lds_cptr kb = opq((lds_cptr)(L + ML_KB + buf * ML_KBSZ + kfrag));
                    f32x16 p0 = {}, p1 = {};
#pragma unroll
                    for (int s = 0; s < 8; ++s) {
                        const bf16x8 k0 = *(const LAS bf16x8*)(kb + s * 2 * ML_KSTR), k1 = *(const LAS bf16x8*)(kb + s * 2 * ML_KSTR + 512);
                        p0 = MFMA32(k0, qf[s], p0); p1 = MFMA32(k1, qf[s], p1);
                        if (s & 1) __builtin_amdgcn_sched_barrier(0);
                    }
                    const LAS float* gk = opq(gt + MNT + 64 * j + 4 * hi);
                    const int iqo = (j == c) ? opq(32 * qh + r32 - 4 * hi) : 1000;
                    float sacc = 0.f;
#pragma unroll
                    for (int r4 = 0; r4 < 4; ++r4) {
                        const f32x4 g0 = *(const LAS f32x4*)(gk + 8 * r4), g1 = *(const LAS f32x4*)(gk + 32 + 8 * r4);
#pragma unroll
                        for (int e = 0; e < 4; ++e) { const int r = 4 * r4 + e, ikr = 8 * r4 + e;
                            float d0 = __builtin_amdgcn_exp2f(g0[e] - Mq), d1 = __builtin_amdgcn_exp2f(g1[e] - Mq);
                            d0 = (ikr > iqo) ? 0.f : d0; d1 = (ikr + 32 > iqo) ? 0.f : d1;
                            p0[r] *= d0; p1[r] *= d1; sacc += p0[r] + p1[r]; }
                    }
                    den += sacc;
#pragma unroll
                    for (int e = 0; e < 4; ++e) { pw[0][e] = cvtpk(p0[2 * e], p0[2 * e + 1]); pw[1][e] = cvtpk(p0[8 + 2 * e], p0[8 + 2 * e + 1]); pw[2][e] = cvtpk(p1[2 * e], p1[2 * e + 1]); pw[3][e] = cvtpk(p1[8 + 2 * e], p1[8 + 2 * e + 1]); }
                }
                asm volatile("" ::: "memory");
                if (more) B3_LOAD(j + 1);
                if (j <= c) {
                    const lds_cptr vb = opq((lds_cptr)(L + ML_VB + buf * 16384 + trl));
#pragma unroll
                    for (int kg = 0; kg < 4; ++kg) {
                        const bf16x8 pa = __builtin_bit_cast(bf16x8, pw[kg]);
                        o0 = MFMA32(pa, mk8(vtr(vb + kg * 1024), vtr(vb + kg * 1024 + 512)), o0);
                        o1 = MFMA32(pa, mk8(vtr(vb + 4096 + kg * 1024), vtr(vb + 4096 + kg * 1024 + 512)), o1);
                        o2 = MFMA32(pa, mk8(vtr(vb + 8192 + kg * 1024), vtr(vb + 8192 + kg * 1024 + 512)), o2);
                        o3 = MFMA32(pa, mk8(vtr(vb + 12288 + kg * 1024), vtr(vb + 12288 + kg * 1024 + 512)), o3);
                        __builtin_amdgcn_sched_barrier(0);
                    }
                }
                if (more) B3_WRITE(buf ^ 1);
                __syncthreads();
            }
            den += __shfl_xor(den, 32);
            den += wint * dn;
            const float mt2 = gt[tq] + Mq;
            const float dd = fmaxf(fabsf(den), __builtin_amdgcn_exp2f(-mt2));
            if (hi == 0) wsf[r32] = 1.0f / dd;
            asm volatile("s_waitcnt lgkmcnt(0)" ::: "memory");
            const unsigned hoff = (unsigned)(((R0 + 64 * c + 32 * qh + 4 * hi) * 512 + 128 * h + r32) * 4);
#pragma unroll
            for (int r = 0; r < 16; ++r) { const float inv = wsf[crow(r, hi)]; float* hp = (float*)((char*)HB + (size_t)opq(hoff + (unsigned)((r & 3) + 8 * (r >> 2)) * 2048u));
                hp[0] = o0[r] * inv; hp[32] = o1[r] * inv; hp[64] = o2[r] * inv; hp[96] = o3[r] * inv; }
            asm volatile("s_waitcnt lgkmcnt(0)" ::: "memory");
        }
#undef B3_LOAD
#undef B3_WRITE
        __syncthreads();
    }
}

__global__ void __launch_bounds__(NWAVES * 64, 2) skel_fwd(Args args) {
    extern __shared__ __attribute__((aligned(16))) unsigned char lds[];
    Frame F;
    F.lds = (LAS unsigned char*)lds;
    F.MISC = (volatile LAS unsigned*)(F.lds + MISC_OFF);
    F.tid = threadIdx.x; F.lane = F.tid & 63; F.wave = __builtin_amdgcn_readfirstlane(F.tid >> 6);
    F.G = gridDim.x; { const int bx = blockIdx.x; F.vcu = (F.G % 8 == 0) ? (bx % 8) * (F.G / 8) + bx / 8 : bx; }
    unsigned char* ws = args.ws; F.ws = ws;
    F.ctl = (gu32*)(ws + WS_CTL);
    for (int u = F.tid; u < (LDS_BYTES - LDSCTL_OFF) / 4; u += NWAVES * 64) ((LAS unsigned*)(F.lds + LDSCTL_OFF))[u] = 0u;
    __syncthreads();
    XcdBarrier bar; bar.bar = (unsigned*)(F.ctl + CW_BAR); bar.x = 0; bar.st = nullptr;
    if (N_LAUNCHES == 1) bar = xcd_barrier_post((unsigned*)(F.ctl + CW_BAR), F.MISC + 8);
#define GRID_BAR() do { if (N_LAUNCHES == 1) xcd_barrier(bar); } while (0)
    const int lo = args.ph_lo, hi = args.ph_hi;
#define IN(k) (lo <= (k) && (k) < hi)
#define BOTH(k) (IN(k) && IN((k) + 1))
    if (IN(0)) { p0_prologue(F, args); if (BOTH(0)) GRID_BAR(); }
#pragma unroll 1
    for (int l = 0; l < 2; ++l) {
        const int p = 1 + 6 * l;
        const float* ss = (l == 0) ? (const float*)(ws + WS_SS0) : (const float*)(ws + WS_SS1);
        if (IN(p)) {
            pg8::Gemm g{(const pg8::bf16_t*)(ws + WS_XN), (const pg8::bf16_t*)(ws + WS_WIN + l * WIN_BYTES), M, NIN, 1024}; pg8::StaticOrder S; S.init(M, NIN, F.G, (int)blockIdx.x);
            pg8::EpiIn E{ws, ss, IN_ATT_Q_G(args) + l * 64, IN_ATT_K_G(args) + l * 64, 0.125f * 1.4426950408889634f};
            pg8::gemm_phase<pg8::EpiIn, pg8::StaticOrder, true, true>(F.lds + RING_OFF, g, S, E);
            gates_phase(F, args, l, ss);
            if (BOTH(p)) GRID_BAR();
        }
        if (IN(p + 1)) { attn_phase(F, args, l); conv_v1(F, args, l); ml_b1(F, args, l); if (BOTH(p + 1)) GRID_BAR(); }
        if (IN(p + 2)) { ml_b2(F); if (BOTH(p + 2)) GRID_BAR(); }
        if (IN(p + 3)) { ml_b3(F, args, l); if (BOTH(p + 3)) GRID_BAR(); }
        if (IN(p + 4)) { mlfin_v1(F, args, l); if (BOTH(p + 4)) GRID_BAR(); }
        if (IN(p + 5)) {
            pg8::Gemm g{(const pg8::bf16_t*)(ws + WS_MIX), (const pg8::bf16_t*)(ws + WS_WOUT + (size_t)l * 2 * MiB), M, DM, 1024}; pg8::StaticOrder S; S.init(M, DM, F.G, (int)blockIdx.x);
            pg8::EpiOut E{(l == 0) ? IN_X(args) : (const float*)args.out, args.out, (l == 0) ? (pg8::bf16_t*)(ws + WS_XN) : nullptr, (float*)(ws + WS_SS1)};
            pg8::gemm_phase<pg8::EpiOut, pg8::StaticOrder, true, true>(F.lds + RING_OFF, g, S, E);
            if (BOTH(p + 5)) GRID_BAR();
        }
    }
#undef IN
#undef BOTH
}

extern "C" void kernel_launch(void* const* d_in, const int* in_sizes, int n_in, void* d_out, int out_size, void* d_ws, size_t ws_size, hipStream_t stream) {
    static int grid = 0;
    if (grid == 0) {
        if (n_in != 16 || in_sizes[0] != M * DM || out_size != M * DM || ws_size < WS_END) { fprintf(stderr, "kernel_launch: unexpected shapes: n_in %d in0 %d out %d ws %zu\n", n_in, n_in > 0 ? in_sizes[0] : -1, out_size, ws_size); grid = -1; return; }
        int dev = 0, cus = 0;
        if (hipGetDevice(&dev) != hipSuccess || hipDeviceGetAttribute(&cus, hipDeviceAttributeMultiprocessorCount, dev) != hipSuccess) { grid = -1; return; }
        if (hipFuncSetAttribute((const void*)skel_fwd, hipFuncAttributeMaxDynamicSharedMemorySize, LDS_BYTES) != hipSuccess) { fprintf(stderr, "kernel_launch: hipFuncSetAttribute failed\n"); grid = -1; return; }
        int per_cu = 0;
        if (hipOccupancyMaxActiveBlocksPerMultiprocessor(&per_cu, (const void*)skel_fwd, NWAVES * 64, LDS_BYTES) != hipSuccess || per_cu < 1) fprintf(stderr, "kernel_launch: occupancy query reports %d\n", per_cu);
        (void)hipGetLastError();
        grid = cus;
    }
    if (grid < 0) return;
    if (hipMemsetAsync((char*)d_ws + WS_CTL, 0, CTL_ZERO_BYTES, stream) != hipSuccess) return;
    Args a{};
    for (int i = 0; i < 16; ++i) a.in[i] = (const float*)d_in[i];
    a.out = (float*)d_out; a.ws = (unsigned char*)d_ws;
    for (int li = 0; li < N_LAUNCHES; ++li) {
        a.ph_lo = (N_LAUNCHES == 1) ? 0 : li; a.ph_hi = (N_LAUNCHES == 1) ? N_PHASES : li + 1; a.li = li;
        hipLaunchKernelGGL(skel_fwd, dim3(grid), dim3(NWAVES * 64), LDS_BYTES, stream, a);
    }
}
```

```cpp
#include <hip/hip_runtime.h>
#include <cstdio>
#include <cstdint>
#ifndef MK_N_LAUNCHES
#define MK_N_LAUNCHES 1
#endif
template <int X> __device__ __forceinline__ float xl_xor(float v) { static_assert(X > 0 && X < 32, "ds_swizzle bit mode"); return __int_as_float(__builtin_amdgcn_ds_swizzle(__float_as_int(v), (X << 10) | 0x1f)); }
__device__ __forceinline__ float xl_sum32(float v) { auto rr = __builtin_amdgcn_permlane32_swap(__float_as_uint(v), __float_as_uint(v), false, false); return __uint_as_float(rr[0]) + __uint_as_float(rr[1]); }
__device__ __forceinline__ float xl_max32(float v) { auto rr = __builtin_amdgcn_permlane32_swap(__float_as_uint(v), __float_as_uint(v), false, false); return fmaxf(__uint_as_float(rr[0]), __uint_as_float(rr[1])); }
__device__ __forceinline__ float xl_wave_sum(float v) { v += xl_xor<1>(v); v += xl_xor<2>(v); v += xl_xor<4>(v); v += xl_xor<8>(v); v += xl_xor<16>(v); return xl_sum32(v); }
__device__ __forceinline__ float xl_wave_max(float v) { v = fmaxf(v, xl_xor<1>(v)); v = fmaxf(v, xl_xor<2>(v)); v = fmaxf(v, xl_xor<4>(v)); v = fmaxf(v, xl_xor<8>(v)); v = fmaxf(v, xl_xor<16>(v)); return xl_max32(v); }
__device__ __forceinline__ float xl_up(float v, int lane, int o) { const int src = (lane >= o) ? lane - o : lane; return __int_as_float(__builtin_amdgcn_ds_bpermute(src << 2, __float_as_int(v))); }
__device__ __forceinline__ int lane_id_now() { unsigned z = 0u; asm volatile("" : "+v"(z)); return (int)__builtin_amdgcn_mbcnt_hi(~0u, __builtin_amdgcn_mbcnt_lo(~0u, z)); }
namespace pg8 {
#define PG8_LAS __attribute__((address_space(3)))
typedef unsigned short bf16_t;
typedef short bf16x8 __attribute__((ext_vector_type(8)));
typedef float f32x4 __attribute__((ext_vector_type(4)));
typedef unsigned u32x4 __attribute__((ext_vector_type(4)));
constexpr int BM = 256, BK = 64, HALF = 128, HTB = HALF * BK * 2  , STAGE_BYTES = 8 * HTB, NXCD = 8, WGM = 8;

__host__ __device__ __forceinline__ int lds_byte(int r, int c) { const int st = (r >> 4) * 2 + (c >> 5), rr = r & 15, cc = c & 31, ob = rr * 64 + cc * 2; return st * 1024 + (ob ^ (((ob >> 9) & 1) << 5)); }
__host__ __device__ __forceinline__ void stage_rc(int b, int& R, int& C) { const int st = b / 1024, sb = b % 1024, swz = sb ^ (((sb >> 9) & 1) << 5); R = (st >> 1) * 16 + swz / 64; C = (st & 1) * 32 + (swz % 64) / 2; }
__host__ __device__ __forceinline__ int perm32(int rho) { const int n = rho >> 4, i = rho & 15; return 8 * (i >> 2) + 4 * n + (i & 3); }

struct Unit { int pm, pn; };
struct Gemm { const bf16_t* A; const bf16_t* Bt; int M, N, K; };

struct StaticOrder {
    int nM, nN, nwg, G, c;
    __host__ __device__ void init(int M, int N, int G_, int c_) { nM = M / BM; nN = N / BM; nwg = nM * nN; G = G_; c = c_; }
    __host__ __device__ bool next(int i, Unit& u) const {
        const long L = (long)i * G + c; if (L >= nwg) return false;
        int wgid = (int)L; { const int q = nwg / NXCD, r = nwg % NXCD, xcd = wgid % NXCD, off = wgid / NXCD; wgid = (xcd < r ? xcd * (q + 1) : r * (q + 1) + (xcd - r) * q) + off; }
        const int nig = WGM * nN, gid = wgid / nig, fm = gid * WGM, gsz = (nM - fm) < WGM ? (nM - fm) : WGM;
        u.pm = fm + ((wgid % nig) % gsz); u.pn = (wgid % nig) / gsz; return true;
    }
    __device__ __forceinline__ void a_ready(const Unit&) const {}
    __device__ __forceinline__ void done(const Unit&) const {}
};

__device__ __forceinline__ unsigned cvt_pk_bf16(float lo, float hi) { unsigned r; asm volatile("v_cvt_pk_bf16_f32 %0, %1, %2" : "=v"(r) : "v"(lo), "v"(hi)); return r; }
__device__ __forceinline__ float sigmoid_f(float x) { return __builtin_amdgcn_rcpf(1.0f + __builtin_amdgcn_exp2f(-1.4426950408889634f * x)); }
__device__ __forceinline__ f32x4 sigmoid4(f32x4 v) { return (f32x4){sigmoid_f(v[0]), sigmoid_f(v[1]), sigmoid_f(v[2]), sigmoid_f(v[3])}; }

struct EpiIn {
    static constexpr bool PERM = true, AFTER_DRAIN = false;
    unsigned char* ws; const float* ss; const float* qg; const float* kg; float qscale;
    __device__ __forceinline__ void operator()(const f32x4 (&acc)[2][2][4][2], const Unit& u, int wr, int wc, int fr, int fq) const {
        const int j = u.pn;
        const int row0 = u.pm * BM + wr * 64 + fr;
        float rs[2][4];
#pragma unroll
        for (int ai = 0; ai < 2; ++ai)
#pragma unroll
            for (int m = 0; m < 4; ++m) rs[ai][m] = 1.0f / sqrtf(ss[row0 + ai * HALF + m * 16] * (1.0f / 1024.0f) + 1e-6f);
        int type, ld, coff; size_t boff;
        if (j < 4) { ld = 256; coff = 0; boff = (size_t)(256 + 32 * j) << 20; type = (j == 0) ? 3 : (j == 1) ? 4 : (j == 2) ? 0 : 1; }
        else if (j < 14) { const int t = (j - 4) >> 1; ld = 512; coff = 256 * ((j - 4) & 1); boff = (size_t)(384 + 64 * t) << 20; type = (t == 3) ? 2 : (t == 4) ? 1 : 0; }
        else if (j < 16) { ld = 256; coff = 128 * (j - 14); boff = (size_t)704 << 20; type = 5; }
        else { ld = 256; coff = 0; boff = (size_t)736 << 20; type = 1; }
        bf16_t* base = (bf16_t*)(ws + boff);
        if (type == 5) {
#pragma unroll
            for (int ai = 0; ai < 2; ++ai)
#pragma unroll
                for (int m = 0; m < 4; ++m) { const float s = rs[ai][m]; bf16_t* p = base + (size_t)(row0 + ai * HALF + m * 16) * ld + coff + 32 * wc + 8 * fq;
                    const f32x4 a0 = acc[ai][0][m][0] * s, a1 = acc[ai][0][m][1] * s, b0 = sigmoid4(acc[ai][1][m][0] * s), b1 = sigmoid4(acc[ai][1][m][1] * s);
                    const f32x4 v0 = a0 * b0, v1 = a1 * b1;
                    u32x4 w; w.x = cvt_pk_bf16(v0[0], v0[1]); w.y = cvt_pk_bf16(v0[2], v0[3]); w.z = cvt_pk_bf16(v1[0], v1[1]); w.w = cvt_pk_bf16(v1[2], v1[3]);
                    *(u32x4*)p = w; }
        } else if (type == 3 || type == 4) {
            const float* gp = (type == 3) ? qg : kg; const float sc = (type == 3) ? qscale : 1.0f;
            f32x4 gv[2][2];
#pragma unroll
            for (int bj = 0; bj < 2; ++bj)
#pragma unroll
                for (int n = 0; n < 2; ++n) gv[bj][n] = *(const f32x4*)(gp + 32 * bj + 8 * fq + 4 * n) * sc;
#pragma unroll
            for (int ai = 0; ai < 2; ++ai)
#pragma unroll
                for (int m = 0; m < 4; ++m) { const float s = rs[ai][m]; bf16_t* p = base + (size_t)(row0 + ai * HALF + m * 16) * ld + coff + 64 * wc + 8 * fq;
                    f32x4 v[2][2]; float q = 0.f;
#pragma unroll
                    for (int bj = 0; bj < 2; ++bj)
#pragma unroll
                        for (int n = 0; n < 2; ++n) { v[bj][n] = acc[ai][bj][m][n] * s; const f32x4 x = v[bj][n]; q += (x[0] * x[0] + x[1] * x[1]) + (x[2] * x[2] + x[3] * x[3]); }
                    q += xl_xor<16>(q); q = xl_sum32(q);
                    const float hr = 1.0f / sqrtf(q * (1.0f / 64.0f) + 1e-6f);
#pragma unroll
                    for (int bj = 0; bj < 2; ++bj) { const f32x4 v0 = v[bj][0] * hr * gv[bj][0], v1 = v[bj][1] * hr * gv[bj][1];
                        u32x4 w; w.x = cvt_pk_bf16(v0[0], v0[1]); w.y = cvt_pk_bf16(v0[2], v0[3]); w.z = cvt_pk_bf16(v1[0], v1[1]); w.w = cvt_pk_bf16(v1[2], v1[3]);
                        *(u32x4*)(p + 32 * bj) = w; } }
        } else {
#pragma unroll
            for (int ai = 0; ai < 2; ++ai)
#pragma unroll
                for (int m = 0; m < 4; ++m) { const float s = rs[ai][m]; bf16_t* p = base + (size_t)(row0 + ai * HALF + m * 16) * ld + coff + 64 * wc + 8 * fq;
#pragma unroll
                    for (int bj = 0; bj < 2; ++bj) { f32x4 v0 = acc[ai][bj][m][0] * s, v1 = acc[ai][bj][m][1] * s;
                        if (type == 1) { v0 = v0 * sigmoid4(v0); v1 = v1 * sigmoid4(v1); }
                        else if (type == 2) { v0 = sigmoid4(v0); v1 = sigmoid4(v1); }
                        u32x4 w; w.x = cvt_pk_bf16(v0[0], v0[1]); w.y = cvt_pk_bf16(v0[2], v0[3]); w.z = cvt_pk_bf16(v1[0], v1[1]); w.w = cvt_pk_bf16(v1[2], v1[3]);
                        *(u32x4*)(p + 32 * bj) = w; } }
        }
    }
};

struct EpiOut {
    static constexpr bool PERM = false, AFTER_DRAIN = false;
    const float* bf; const bf16_t* bb; float* outf; bf16_t* outb; float* ssq;
    __device__ __forceinline__ void operator()(const f32x4 (&acc)[2][2][4][2], const Unit& u, int wr, int wc, int fr, int fq) const {
        typedef unsigned u32x2v __attribute__((ext_vector_type(2)));
        const int row0 = u.pm * BM + wr * 64 + fr, col0 = u.pn * BM + wc * 32 + 4 * fq;
#pragma unroll
        for (int ai = 0; ai < 2; ++ai)
#pragma unroll
            for (int m = 0; m < 4; ++m) { const int r = row0 + ai * HALF + m * 16; const size_t off = (size_t)r * 1024 + col0; float q = 0.f;
#pragma unroll
                for (int bj = 0; bj < 2; ++bj)
#pragma unroll
                    for (int n = 0; n < 2; ++n) { const size_t o2 = off + bj * HALF + n * 16; f32x4 o;
                        if (bf) o = *(const f32x4*)(bf + o2);
                        else { const u32x2v w = *(const u32x2v*)(bb + o2); o = (f32x4){__uint_as_float(w.x << 16), __uint_as_float(w.x & 0xffff0000u), __uint_as_float(w.y << 16), __uint_as_float(w.y & 0xffff0000u)}; }
                        o = o + acc[ai][bj][m][n];
                        if (outf) *(f32x4*)(outf + o2) = o;
                        if (outb) { u32x2v w; w.x = cvt_pk_bf16(o[0], o[1]); w.y = cvt_pk_bf16(o[2], o[3]); *(u32x2v*)(outb + o2) = w; q += (o[0] * o[0] + o[1] * o[1]) + (o[2] * o[2] + o[3] * o[3]); } }
                if (outb) { q += xl_xor<16>(q); q = xl_sum32(q); if (fq == 0) atomicAdd(ssq + r, q); } }
    }
};

template <class Epi, class Sched, bool ALIGN_EPI = false, bool SP2 = false>
__device__ __forceinline__ void gemm_phase(PG8_LAS unsigned char* lds, const Gemm g, const Sched& S, const Epi& E, const int wave_id) {
    int tid_ = wave_id * 64 + lane_id_now(); asm volatile("" : "+v"(tid_));
    const int tid = tid_, wid = __builtin_amdgcn_readfirstlane(tid >> 6), lane = tid & 63, wr = wid >> 2, wc = wid & 3, fr = lane & 15, fq = lane >> 4;
    const int K = g.K, nt = K / BK;
    unsigned voffA[2], voffB[2];
#pragma unroll
    for (int i = 0; i < 2; ++i) { int R, C; stage_rc(tid * 16 + i * 8192, R, C); const int Rb = Epi::PERM ? ((R & ~31) + perm32(R & 31)) : R;
        voffA[i] = (unsigned)(R * K + C) * 2u; voffB[i] = (unsigned)(Rb * K + C) * 2u; }
    const size_t kstep = (size_t)(BK * 2);
    const size_t hstep = (size_t)HALF * K * 2;
    const size_t tstep = 2 * hstep;
    const unsigned ldsw = (unsigned)wid * 1024u;
    const int aoff = lds_byte(wr * 64 + fr, fq * 8), boff = lds_byte(wc * 32 + fr, fq * 8);
#define PG8_SA(b, h) (((b) * 2 + (h)) * HTB)
#define PG8_SB(b, h) ((4 + (b) * 2 + (h)) * HTB)
#define PG8_STAGE(bufoff, gbase, voff) do { _Pragma("unroll") for (int _i = 0; _i < 2; ++_i) \
        __builtin_amdgcn_global_load_lds((const unsigned*)((const char*)(gbase) + (voff)[_i]), (PG8_LAS unsigned*)(lds + (bufoff) + ldsw + _i * 8192), 16, 0, 0); } while (0)
#define PG8_LDA(dst, b, h) do { _Pragma("unroll") for (int m = 0; m < 4; ++m) _Pragma("unroll") for (int k = 0; k < 2; ++k) dst[m][k] = *(const PG8_LAS bf16x8*)(lds + PG8_SA(b, h) + aoff + m * 2048 + k * 1024); } while (0)
#define PG8_LDB(dst, b, h) do { _Pragma("unroll") for (int n = 0; n < 2; ++n) _Pragma("unroll") for (int k = 0; k < 2; ++k) dst[n][k] = *(const PG8_LAS bf16x8*)(lds + PG8_SB(b, h) + boff + n * 2048 + k * 1024); } while (0)
#define PG8_MMA(ai, bj, At, Bt) do { __builtin_amdgcn_s_setprio(1); _Pragma("unroll") for (int m = 0; m < 4; ++m) _Pragma("unroll") for (int n = 0; n < 2; ++n) _Pragma("unroll") for (int k = 0; k < 2; ++k) \
        acc[ai][bj][m][n] = __builtin_amdgcn_mfma_f32_16x16x32_bf16(Bt[n][k], At[m][k], acc[ai][bj][m][n], 0, 0, 0); __builtin_amdgcn_s_setprio(0); } while (0)
#define PG8_WAIT_V(n) asm volatile("s_waitcnt vmcnt(" #n ")" ::: "memory")
#define PG8_WAIT_L(n) asm volatile("s_waitcnt lgkmcnt(" #n ")" ::: "memory")
#define PG8_BAR __builtin_amdgcn_s_barrier()
#define PG8_SCHED __builtin_amdgcn_sched_barrier(0)
    Unit cur, nxt; int ui = 0;
    if (!S.next(0, cur)) return;
    f32x4 acc[2][2][4][2];
#pragma unroll
    for (int a = 0; a < 2; ++a)
#pragma unroll
        for (int b = 0; b < 2; ++b)
#pragma unroll
            for (int m = 0; m < 4; ++m)
#pragma unroll
                for (int n = 0; n < 2; ++n) acc[a][b][m][n] = (f32x4){0.f, 0.f, 0.f, 0.f};
    bf16x8 At[4][2], B0[2][2], B1[2][2];
    const char* cA = (const char*)g.A + (size_t)cur.pm * tstep; const char* cB = (const char*)g.Bt + (size_t)cur.pn * tstep;
    S.a_ready(cur);
    if constexpr (SP2) {
        PG8_STAGE(PG8_SB(0, 0), cB, voffB); PG8_STAGE(PG8_SB(0, 1), cB + hstep, voffB); PG8_STAGE(PG8_SA(0, 0), cA, voffA); PG8_STAGE(PG8_SA(0, 1), cA + hstep, voffA);
        if (wr == 1) PG8_BAR;
        PG8_WAIT_V(2); PG8_BAR;
        PG8_STAGE(PG8_SB(1, 0), cB + kstep, voffB); PG8_STAGE(PG8_SA(1, 0), cA + kstep, voffA); PG8_STAGE(PG8_SB(1, 1), cB + hstep + kstep, voffB);
        PG8_WAIT_V(6); PG8_BAR;
    } else {
        PG8_STAGE(PG8_SB(0, 0), cB, voffB); PG8_STAGE(PG8_SA(0, 0), cA, voffA); PG8_STAGE(PG8_SB(0, 1), cB + hstep, voffB); PG8_STAGE(PG8_SA(0, 1), cA + hstep, voffA);
        if (wr == 1) PG8_BAR;
        PG8_WAIT_V(4); PG8_BAR;
        PG8_STAGE(PG8_SB(1, 0), cB + kstep, voffB); PG8_STAGE(PG8_SA(1, 0), cA + kstep, voffA); PG8_STAGE(PG8_SB(1, 1), cB + hstep + kstep, voffB);
        PG8_WAIT_V(6); PG8_BAR;
    }
    for (;;) {
        const bool has_next = S.next(ui + 1, nxt);
        const char* nA = has_next ? (const char*)g.A + (size_t)nxt.pm * tstep : cA; const char* nB = has_next ? (const char*)g.Bt + (size_t)nxt.pn * tstep : cB;
        for (int t = 0; t < nt; t += 2) {
            const bool last = (t == nt - 2);
            const char* a1 = cA + (size_t)(t + 1) * kstep;
            const char* a2 = last ? nA : cA + (size_t)(t + 2) * kstep; const char* b2 = last ? nB : cB + (size_t)(t + 2) * kstep;
            const char* a3 = a2 + kstep; const char* b3 = b2 + kstep;
            if (last && has_next) S.a_ready(nxt);
            if constexpr (SP2) {
            PG8_LDB(B0, 0, 0); PG8_LDB(B1, 0, 1); PG8_SCHED; PG8_LDA(At, 0, 0); PG8_STAGE(PG8_SA(1, 1), a1 + hstep, voffA);
            PG8_WAIT_V(8); PG8_WAIT_L(0); PG8_BAR; PG8_MMA(0, 0, At, B0); PG8_MMA(0, 1, At, B1); PG8_BAR; PG8_SCHED;
            PG8_LDA(At, 0, 1); PG8_STAGE(PG8_SB(0, 0), b2, voffB); PG8_STAGE(PG8_SB(0, 1), b2 + hstep, voffB); PG8_STAGE(PG8_SA(0, 0), a2, voffA);
            PG8_WAIT_V(8); PG8_WAIT_L(0); PG8_BAR; PG8_MMA(1, 0, At, B0); PG8_MMA(1, 1, At, B1); PG8_BAR; PG8_SCHED;
            PG8_LDB(B0, 1, 0); PG8_LDB(B1, 1, 1); PG8_SCHED; PG8_LDA(At, 1, 0); PG8_STAGE(PG8_SA(0, 1), a2 + hstep, voffA);
            PG8_WAIT_V(8); PG8_WAIT_L(0); PG8_BAR; PG8_MMA(0, 0, At, B0); PG8_MMA(0, 1, At, B1); PG8_BAR; PG8_SCHED;
            PG8_LDA(At, 1, 1); PG8_STAGE(PG8_SB(1, 0), b3, voffB); PG8_STAGE(PG8_SB(1, 1), b3 + hstep, voffB); PG8_STAGE(PG8_SA(1, 0), a3, voffA);
            PG8_WAIT_V(8); PG8_WAIT_L(0); PG8_BAR; PG8_MMA(1, 0, At, B0); PG8_MMA(1, 1, At, B1); PG8_BAR; PG8_SCHED;
            } else {
            PG8_LDB(B0, 0, 0); PG8_SCHED; PG8_LDA(At, 0, 0); PG8_STAGE(PG8_SA(1, 1), a1 + hstep, voffA);
            PG8_WAIT_L(8); PG8_BAR; PG8_WAIT_L(0); PG8_MMA(0, 0, At, B0); PG8_BAR; PG8_SCHED;
            PG8_LDB(B1, 0, 1); PG8_STAGE(PG8_SB(0, 0), b2, voffB);
            PG8_BAR; PG8_WAIT_L(0); PG8_MMA(0, 1, At, B1); PG8_BAR;
            PG8_LDA(At, 0, 1); PG8_STAGE(PG8_SA(0, 0), a2, voffA);
            PG8_BAR; PG8_WAIT_L(0); PG8_MMA(1, 0, At, B0); PG8_BAR; PG8_SCHED;
            PG8_STAGE(PG8_SB(0, 1), b2 + hstep, voffB);
            PG8_WAIT_V(6); PG8_BAR; PG8_MMA(1, 1, At, B1); PG8_BAR;
            PG8_LDB(B0, 1, 0); PG8_SCHED; PG8_LDA(At, 1, 0); PG8_STAGE(PG8_SA(0, 1), a2 + hstep, voffA);
            PG8_WAIT_L(8); PG8_BAR; PG8_WAIT_L(0); PG8_MMA(0, 0, At, B0); PG8_BAR; PG8_SCHED;
            PG8_LDB(B1, 1, 1); PG8_STAGE(PG8_SB(1, 0), b3, voffB);
            PG8_BAR; PG8_WAIT_L(0); PG8_MMA(0, 1, At, B1); PG8_BAR;
            PG8_LDA(At, 1, 1); PG8_STAGE(PG8_SA(1, 0), a3, voffA);
            PG8_BAR; PG8_WAIT_L(0); PG8_MMA(1, 0, At, B0); PG8_BAR; PG8_SCHED;
            PG8_STAGE(PG8_SB(1, 1), b3 + hstep, voffB);
            PG8_WAIT_V(6); PG8_BAR; PG8_MMA(1, 1, At, B1); PG8_BAR;
            }
        }
        if constexpr (ALIGN_EPI) { if (wr == 0) PG8_BAR; }
        if constexpr (!Epi::AFTER_DRAIN) { E(acc, cur, wr, wc, fr, fq); S.done(cur); }
        if (!has_next) break;
#pragma unroll
        for (int a = 0; a < 2; ++a)
#pragma unroll
            for (int b = 0; b < 2; ++b)
#pragma unroll
                for (int m = 0; m < 4; ++m)
#pragma unroll
                    for (int n = 0; n < 2; ++n) acc[a][b][m][n] = (f32x4){0.f, 0.f, 0.f, 0.f};
        cur = nxt; cA = nA; cB = nB; ++ui;
        if constexpr (ALIGN_EPI) { if (wr == 1) PG8_BAR; }
    }
    PG8_WAIT_V(0);
    if constexpr (!ALIGN_EPI) { if (wr == 0) PG8_BAR; }
    PG8_BAR;
    if constexpr (Epi::AFTER_DRAIN) { E.fused(acc, cur, wr, wc, fr, fq, lds, wid, lane); S.done(cur); }
#undef PG8_SA
#undef PG8_SB
#undef PG8_STAGE
#undef PG8_LDA
#undef PG8_LDB
#undef PG8_MMA
#undef PG8_WAIT_V
#undef PG8_WAIT_L
#undef PG8_BAR
#undef PG8_SCHED
}
}
#define GAS __attribute__((address_space(1)))
#define LAS __attribute__((address_space(3)))
typedef unsigned short bf16;
typedef unsigned v4u __attribute__((ext_vector_type(4)));
typedef float f32x4 __attribute__((ext_vector_type(4)));
typedef short bf16x8 __attribute__((ext_vector_type(8)));
typedef GAS unsigned gu32;
typedef GAS unsigned long long gu64;
#define RLX_AGENT __ATOMIC_RELAXED, __HIP_MEMORY_SCOPE_AGENT
#define LDS_WAIT() asm volatile("s_waitcnt lgkmcnt(0)" ::: "memory")
#define VM_WAIT() asm volatile("s_waitcnt vmcnt(0)" ::: "memory")
__device__ __forceinline__ unsigned long long rt() { return __builtin_amdgcn_s_memrealtime(); }
__device__ __forceinline__ unsigned f2bf(float f) { unsigned u = __builtin_bit_cast(unsigned, f); return (u + 0x7fffu + ((u >> 16) & 1u)) >> 16; }
__device__ __forceinline__ unsigned pk2(float lo, float hi) { return f2bf(lo) | (f2bf(hi) << 16); }

#define XB_TMO      128
#define XB_XCNT(j)  (256  + 64 * (j))
#define XB_XSUB(j)  (1280 + 64 * (j))
#define XB_XGEN(j)  (2304 + 64 * (j))
#define XB_TOP      3328
#define XB_TOPGEN   3392
#define XCD_BAR_WORDS 3456
#define XB_SPIN_CAP (1u << 18)

__device__ __forceinline__ unsigned xb_ld(unsigned* p)              { return __hip_atomic_load(p, __ATOMIC_RELAXED, __HIP_MEMORY_SCOPE_AGENT); }
__device__ __forceinline__ unsigned xb_add(unsigned* p, unsigned v) { return __hip_atomic_fetch_add(p, v, __ATOMIC_RELAXED, __HIP_MEMORY_SCOPE_AGENT); }
__device__ __forceinline__ unsigned xb_xcc_id() { return (unsigned)__builtin_amdgcn_s_getreg((3 << 11) | 20) & 0xFu; }
#define XB_SPIN(cond, bar) do { unsigned _sp = 0; while (cond) { __builtin_amdgcn_s_sleep(1); \
    if ((++_sp & 255u) == 0u) { if (xb_ld(&(bar)[XB_TMO])) break; if (_sp > XB_SPIN_CAP) { atomicAdd(&(bar)[XB_TMO], 1u); break; } } } } while (0)

struct XcdBarrier {
    unsigned* bar; unsigned x;
    volatile LAS unsigned* st;
};

__device__ __forceinline__ XcdBarrier xcd_barrier_post(unsigned* bar, volatile LAS unsigned* st) {
    XcdBarrier b; b.bar = bar; b.x = xb_xcc_id(); b.st = st;
    if (threadIdx.x == 0) (void)xb_add(&bar[XB_XCNT(b.x)], 1u);
    return b;
}
__device__ __forceinline__ void xcd_barrier_complete(unsigned* bar, unsigned x, unsigned& nloc, unsigned& nx) {
    const unsigned G = gridDim.x * gridDim.y * gridDim.z;
    unsigned sum, cnt, mine, sp = 0u;
    for (;;) {
        sum = 0u; cnt = 0u; mine = 0u;
#pragma unroll
        for (unsigned j = 0; j < 16; ++j) { const unsigned c = xb_ld(&bar[XB_XCNT(j)]); sum += c; cnt += (c > 0u) ? 1u : 0u; mine = (j == x) ? c : mine; }
        if (sum == G) break;
        __builtin_amdgcn_s_sleep(1);
        if ((++sp & 255u) == 0u) { if (xb_ld(&bar[XB_TMO])) break; if (sp > XB_SPIN_CAP) { atomicAdd(&bar[XB_TMO], 1u); break; } }
    }
    nloc = mine > 0u ? mine : 1u; nx = cnt > 0u ? cnt : 1u;
}

__device__ __forceinline__ void xcd_barrier(const XcdBarrier& b) {
    asm volatile("s_waitcnt vmcnt(0)" ::: "memory");
    __syncthreads();
    if (threadIdx.x == 0) {
        unsigned* bar = b.bar;
        __builtin_amdgcn_s_waitcnt(0);
        unsigned nloc = b.st[0], nx = b.st[1];
        if (nloc == 0u) { xcd_barrier_complete(bar, b.x, nloc, nx); b.st[0] = nloc; b.st[1] = nx; }
        const unsigned old = xb_add(&bar[XB_XSUB(b.x)], 1u);
        const unsigned gen = old / nloc;
        if (old + 1u == (gen + 1u) * nloc) {
            __builtin_amdgcn_fence(__ATOMIC_RELEASE, "agent");
            asm volatile("s_waitcnt vmcnt(0)" ::: "memory");
            const unsigned og = xb_add(&bar[XB_TOP], 1u);
            const unsigned tg = og / nx;
            if (og + 1u == (tg + 1u) * nx) xb_add(&bar[XB_TOPGEN], 1u);
            else XB_SPIN(xb_ld(&bar[XB_TOPGEN]) == tg, bar);
            __builtin_amdgcn_fence(__ATOMIC_ACQUIRE, "agent");
            xb_add(&bar[XB_XGEN(b.x)], 1u);
            asm volatile("s_waitcnt vmcnt(0)" ::: "memory");
        } else {
            XB_SPIN(xb_ld(&bar[XB_XGEN(b.x)]) == gen, bar);
            __builtin_amdgcn_fence(__ATOMIC_ACQUIRE, "agent");
            asm volatile("s_waitcnt vmcnt(0)" ::: "memory");
        }
    }
    __syncthreads();
}

constexpr int NWAVES = 8;
constexpr int BATCH = 8, SEQ = 8192, DM = 1024, M = BATCH * SEQ;
constexpr int DIN = 4360, NIN = 4352;
constexpr float EPS = 1e-6f;
#ifndef MK_N_LAUNCHES
#define MK_N_LAUNCHES 13
#endif
constexpr int N_PHASES = 13;
constexpr int N_LAUNCHES = MK_N_LAUNCHES;

constexpr size_t MiB = 1u << 20;
constexpr size_t WS_CTL = 0, CTL_ZERO_BYTES = 1 * MiB;
constexpr size_t WS_SS1 = 512 * 1024;
constexpr size_t WS_WIN = 2 * MiB;
constexpr size_t WIN_BYTES = (size_t)NIN * 1024 * 2;
constexpr size_t WS_WG = 20 * MiB;
constexpr size_t WS_WOUT = 21 * MiB;
constexpr size_t WS_SS0 = 26 * MiB;
constexpr size_t WS_IG = 27 * MiB, WS_LF = 28 * MiB;
constexpr size_t WS_XN = 128 * MiB;
constexpr size_t WS_AQ = 256 * MiB, WS_AK = 288 * MiB, WS_AV = 320 * MiB, WS_AZ = 352 * MiB;
constexpr size_t WS_MQ = 384 * MiB, WS_MK = 448 * MiB, WS_MV = 512 * MiB, WS_MO = 576 * MiB, WS_MZ = 640 * MiB;
constexpr size_t WS_CU = 704 * MiB, WS_CZ = 736 * MiB;
constexpr size_t WS_MIX = 768 * MiB;
constexpr size_t WS_HB = 896 * MiB;
constexpr size_t WS_END = 1024 * MiB;
constexpr int CW_TMO = 0, CW_CODE = 1;
constexpr int CW_BAR = 4096;

constexpr int RING_OFF = 0, RING_BYTES = 131072;
constexpr int LDSCTL_OFF = 139264, MISC_OFF = LDSCTL_OFF + 320;
constexpr int LDS_BYTES = 147456;


struct Frame {
    LAS unsigned char* lds;
    volatile LAS unsigned* MISC;
    gu32* ctl;
    int wave;
    int vcu, G;
    unsigned char* ws;
};
#define IN_X(a) ((a).in[0])
#define IN_NORM_G(a) ((a).in[1])
#define IN_W_IN(a) ((a).in[2])
#define IN_ATT_Q_G(a) ((a).in[3])
#define IN_ATT_K_G(a) ((a).in[4])
#define IN_REL_BIAS(a) ((a).in[5])
#define IN_ML_CONV_W(a) ((a).in[6])
#define IN_ML_CONV_B(a) ((a).in[7])
#define IN_ML_B_I(a) ((a).in[8])
#define IN_ML_B_F(a) ((a).in[9])
#define IN_ML_OUT_G(a) ((a).in[10])
#define IN_CV_DW_W(a) ((a).in[11])
#define IN_CV_DW_B(a) ((a).in[12])
#define IN_CV_LN_G(a) ((a).in[13])
#define IN_CV_LN_B(a) ((a).in[14])
#define IN_W_OUT(a) ((a).in[15])
struct Args { const float* in[16]; float* out; unsigned char* ws; int ph_lo, ph_hi, li, pad; };
__device__ __forceinline__ float bf2f(unsigned short h) { return __uint_as_float((unsigned)h << 16); }
__device__ __forceinline__ float bflo(unsigned w) { return __uint_as_float(w << 16); }
__device__ __forceinline__ float bfhi(unsigned w) { return __uint_as_float(w & 0xffff0000u); }
__device__ __forceinline__ float wave_sum(float v) { return xl_wave_sum(v); }
__device__ __forceinline__ float wave_max(float v) { return xl_wave_max(v); }
typedef float f32x16v __attribute__((ext_vector_type(16)));
__device__ __forceinline__ float sigm(float x) { return 1.0f / (1.0f + __expf(-x)); }

__device__ __forceinline__ int in_src_col(int j, int g) {
    const int bj = g >> 2, wc = g & 3;
    if (j < 4) return 256 * j + 64 * wc + 32 * bj;
    if (j < 14) return 1024 + 512 * ((j - 4) >> 1) + 256 * ((j - 4) & 1) + 64 * wc + 32 * bj;
    if (j < 16) return (bj == 0 ? 3592 : 3848) + 128 * (j - 14) + 32 * wc;
    return 4104 + 64 * wc + 32 * bj;
}
__device__ __forceinline__ void p0_transpose_item(const float* W, int ldw, int src0, int k0, const float* gain, bf16* WT, int K, int n0, LAS float* scr, int lane) {
#pragma unroll 8
    for (int i = 0; i < 32; ++i) { const int kk = 2 * i + (lane >> 5); float v = W[(size_t)(k0 + kk) * ldw + src0 + (lane & 31)]; if (gain) v *= gain[k0 + kk]; scr[kk * 33 + (lane & 31)] = v; }
    LDS_WAIT(); asm volatile("" ::: "memory");
    const int c = lane & 7;
#pragma unroll
    for (int jj = 0; jj < 4; ++jj) { const int n = (lane >> 3) + 8 * jj; const LAS float* s = scr + (8 * c) * 33 + n;
        v4u o; o.x = pk2(s[0 * 33], s[1 * 33]); o.y = pk2(s[2 * 33], s[3 * 33]); o.z = pk2(s[4 * 33], s[5 * 33]); o.w = pk2(s[6 * 33], s[7 * 33]);
        *(GAS v4u*)(WT + (size_t)(n0 + n) * K + k0 + 8 * c) = o; }
    LDS_WAIT(); asm volatile("" ::: "memory");
}
__device__ __forceinline__ void p0_prologue(Frame& F, const Args& A) {
    LAS float* scr = (LAS float*)(F.lds + RING_OFF + F.wave * 16384);
    const int gw = F.vcu * NWAVES + F.wave, NGW = F.G * NWAVES;
    constexpr int I_IN = 16 * (NIN / 32), I_OUT = 16 * 32, I_L = I_IN + I_OUT;
    for (int it = gw; it < 2 * I_L; it += NGW) {
        const int l = it / I_L; int r = it % I_L;
        if (r < I_IN) { const int kb = r / (NIN / 32), ng = r % (NIN / 32);
            p0_transpose_item(IN_W_IN(A) + (size_t)l * 1024 * DIN, DIN, in_src_col(ng >> 3, ng & 7), 64 * kb, IN_NORM_G(A) + l * 1024, (bf16*)(F.ws + WS_WIN + l * WIN_BYTES), 1024, 32 * ng, scr, (lane_id_now())); }
        else { r -= I_IN; const int kb = r / 32, nb = r % 32;
            p0_transpose_item(IN_W_OUT(A) + (size_t)l * 1024 * 1024, 1024, 32 * nb, 64 * kb, nullptr, (bf16*)(F.ws + WS_WOUT + (size_t)l * 2 * MiB), 1024, 32 * nb, scr, (lane_id_now())); }
    }
    { bf16* WG = (bf16*)(F.ws + WS_WG);
      for (int e = gw * 64 + (lane_id_now()); e < 2 * 8 * 1024; e += NGW * 64) { const int l = e >> 13, j = (e >> 10) & 7, k = e & 1023;
          WG[e] = (bf16)f2bf(IN_NORM_G(A)[l * 1024 + k] * IN_W_IN(A)[(size_t)l * 1024 * DIN + (size_t)k * DIN + 3584 + j]); } }
    bf16* XN = (bf16*)(F.ws + WS_XN); float* SS0 = (float*)(F.ws + WS_SS0);
    for (int m = gw; m < M; m += NGW) {
        const GAS f32x4* xr = (const GAS f32x4*)(IN_X(A) + (size_t)m * DM) + (lane_id_now());
        f32x4 v[4]; float s2 = 0.f;
#pragma unroll
        for (int j = 0; j < 4; ++j) { v[j] = xr[64 * j]; s2 += (v[j].x * v[j].x + v[j].y * v[j].y) + (v[j].z * v[j].z + v[j].w * v[j].w); }
        s2 = wave_sum(s2);
        GAS unsigned long long* o8 = (GAS unsigned long long*)(XN + (size_t)m * DM) + (lane_id_now());
#pragma unroll
        for (int j = 0; j < 4; ++j) o8[64 * j] = (unsigned long long)pk2(v[j].x, v[j].y) | ((unsigned long long)pk2(v[j].z, v[j].w) << 32);
        if ((lane_id_now()) == 0) SS0[m] = s2;
    }
}

__device__ __forceinline__ void gates_phase(Frame& F, const Args& A, int l, const float* ss) {
    int lane_ = (lane_id_now()); asm volatile("" : "+v"(lane_));
    const int lane = lane_, r32 = lane & 31, hi = lane >> 5;
    const int gw = F.vcu * NWAVES + F.wave, NGW = F.G * NWAVES;
    const bf16* WG = (const bf16*)(F.ws + WS_WG) + l * 8192;
    const bf16* XN = (const bf16*)(F.ws + (l == 0 ? WS_XN : WS_HB));
    float* IG = (float*)(F.ws + WS_IG); float* LF = (float*)(F.ws + WS_LF);
    LAS unsigned char* L = F.lds;
    { const int t = F.wave * 64 + lane;
#pragma unroll
      for (int i = 0; i < 2; ++i) { const int pc = t + 512 * i; *(LAS v4u*)(L + (pc >> 7) * 2064 + (pc & 127) * 16) = *(const v4u*)(WG + pc * 8); } }
    __syncthreads();
    const LAS unsigned char* wb = L + (r32 & 7) * 2064 + hi * 16;
    const float bi = IN_ML_B_I(A)[l * 4 + (r32 & 3)], bfv = IN_ML_B_F(A)[l * 4 + (r32 & 3)];
    for (int task = gw; task < M / 32; task += NGW) {
        const char* xp = (const char*)XN + ((size_t)(32 * task + r32) * 1024 + 8 * hi) * 2;
        f32x16v acc = {};
#pragma unroll 16
        for (int s = 0; s < 64; ++s) {
            const bf16x8 a = *(const bf16x8*)(xp + 32 * s), b = *(const LAS bf16x8*)(wb + 32 * s);
            acc = __builtin_amdgcn_mfma_f32_32x32x16_bf16(a, b, acc, 0, 0, 0);
        }
        if (r32 < 8) {
#pragma unroll
            for (int r = 0; r < 16; ++r) { const int m = 32 * task + (r & 3) + 8 * (r >> 2) + 4 * hi;
                const float v = acc[r] / sqrtf(ss[m] * (1.0f / 1024.0f) + EPS);
                if (r32 < 4) IG[(size_t)m * 4 + r32] = v + bi;
                else { const float fp = v + bfv; LF[(size_t)m * 4 + (r32 & 3)] = fminf(fp, 0.f) - log1pf(__expf(-fabsf(fp))); } }
        }
    }
    __syncthreads();
}

__device__ __forceinline__ void attn_v1(Frame& F, const Args& A, int l) {
    int lane_ = (lane_id_now()); asm volatile("" : "+v"(lane_)); const int gw = F.vcu * NWAVES + F.wave, NGW = F.G * NWAVES, lane = lane_;
    const bf16* AQ = (const bf16*)(F.ws + WS_AQ); const bf16* AK = (const bf16*)(F.ws + WS_AK); const bf16* AV = (const bf16*)(F.ws + WS_AV); const bf16* AZ = (const bf16*)(F.ws + WS_AZ);
    bf16* MIX = (bf16*)(F.ws + WS_MIX);
    for (int it = gw; it < M * 4; it += NGW) {
        const int m = it >> 2, h = it & 3, b = m >> 13, t = m & 8191, c = t >> 6, i = t & 63;
        const float* bias = IN_REL_BIAS(A) + (l * 4 + h) * 257;
        float q[64];
        { const v4u* qp = (const v4u*)(AQ + (size_t)m * 256 + 64 * h);
#pragma unroll
          for (int cc = 0; cc < 8; ++cc) { const v4u w = qp[cc]; q[8 * cc + 0] = bflo(w.x); q[8 * cc + 1] = bfhi(w.x); q[8 * cc + 2] = bflo(w.y); q[8 * cc + 3] = bfhi(w.y); q[8 * cc + 4] = bflo(w.z); q[8 * cc + 5] = bfhi(w.z); q[8 * cc + 6] = bflo(w.w); q[8 * cc + 7] = bfhi(w.w); } }
        float s[9]; float mx = -3.0e38f;
#pragma unroll
        for (int g = 0; g < 9; ++g) {
            const int cb = c - 8 + g;
            if (cb >= 0) {
                const int row = b * SEQ + 64 * cb + lane;
                const v4u* kp = (const v4u*)(AK + (size_t)row * 256 + 64 * h);
                float dot = 0.f;
#pragma unroll
                for (int cc = 0; cc < 8; ++cc) { const v4u w = kp[cc];
                    dot += q[8 * cc + 0] * bflo(w.x) + q[8 * cc + 1] * bfhi(w.x) + q[8 * cc + 2] * bflo(w.y) + q[8 * cc + 3] * bfhi(w.y)
                         + q[8 * cc + 4] * bflo(w.z) + q[8 * cc + 5] * bfhi(w.z) + q[8 * cc + 6] * bflo(w.w) + q[8 * cc + 7] * bfhi(w.w); }
                int rel = i - (64 * g + lane) + 512; rel = rel < -128 ? -128 : (rel > 128 ? 128 : rel);
                s[g] = dot + bias[rel + 128];
                mx = fmaxf(mx, s[g]);
            } else s[g] = -3.0e38f;
        }
        mx = wave_max(mx);
        float lsum = 0.f;
#pragma unroll
        for (int g = 0; g < 9; ++g) { s[g] = (c - 8 + g >= 0) ? __expf(s[g] - mx) : 0.f; lsum += s[g]; }
        lsum = wave_sum(lsum);
        float o = 0.f;
#pragma unroll
        for (int g = 0; g < 9; ++g) {
            const int cb = c - 8 + g;
            if (cb >= 0) {
                const bf16* vp = AV + (size_t)(b * SEQ + 64 * cb) * 256 + 64 * h + lane;
                for (int jj = 0; jj < 64; ++jj) { const float pj = __shfl(s[g], jj); o += pj * bf2f(vp[(size_t)jj * 256]); }
            }
        }
        const float r = o / lsum * bf2f(AZ[(size_t)m * 256 + 64 * h + lane]);
        MIX[(size_t)m * 1024 + 64 * h + lane] = (bf16)f2bf(r);
    }
}

__device__ __forceinline__ void conv_v1(Frame& F, const Args& A, int l) {
    int lane_ = (lane_id_now()); asm volatile("" : "+v"(lane_)); const int gw = F.vcu * NWAVES + F.wave, NGW = F.G * NWAVES, lane = lane_;
    const bf16* CU = (const bf16*)(F.ws + WS_CU); const bf16* CZ = (const bf16*)(F.ws + WS_CZ); bf16* MIX = (bf16*)(F.ws + WS_MIX);
    const float* W = IN_CV_DW_W(A) + l * 31 * 256;
    for (int m = gw; m < M; m += NGW) {
        const int b = m >> 13, t = m & 8191;
        float a[4];
#pragma unroll
        for (int k = 0; k < 4; ++k) a[k] = IN_CV_DW_B(A)[l * 256 + lane + 64 * k];
        for (int j = 0; j < 31; ++j) { const int tt = t - 30 + j;
            if (tt >= 0) { const bf16* up = CU + (size_t)(b * SEQ + tt) * 256 + lane;
#pragma unroll
                for (int k = 0; k < 4; ++k) a[k] += bf2f(up[64 * k]) * W[j * 256 + lane + 64 * k]; } }
        const float mean = wave_sum((a[0] + a[1]) + (a[2] + a[3])) * (1.0f / 256.0f);
        float q = 0.f;
#pragma unroll
        for (int k = 0; k < 4; ++k) { a[k] -= mean; q += a[k] * a[k]; }
        const float rstd = 1.0f / sqrtf(wave_sum(q) * (1.0f / 256.0f) + EPS);
#pragma unroll
        for (int k = 0; k < 4; ++k) { const int ch = lane + 64 * k; float y = a[k] * rstd * IN_CV_LN_G(A)[l * 256 + ch] + IN_CV_LN_B(A)[l * 256 + ch];
            y = y * sigm(y); y *= bf2f(CZ[(size_t)m * 256 + ch]);
            MIX[(size_t)m * 1024 + 768 + ch] = (bf16)f2bf(y); }
    }
}

__device__ __forceinline__ void mlstm_v1(Frame& F, const Args& A, int l) {
    const bf16* MQ = (const bf16*)(F.ws + WS_MQ); const bf16* MK = (const bf16*)(F.ws + WS_MK); const bf16* MV = (const bf16*)(F.ws + WS_MV);
    const float* IG = (const float*)(F.ws + WS_IG); const float* LF = (const float*)(F.ws + WS_LF); float* HB = (float*)(F.ws + WS_HB);
    int tid_ = F.wave * 64 + lane_id_now(); asm volatile("" : "+v"(tid_)); const int vv = tid_ >> 5, kg = tid_ & 31;
    for (int it = blockIdx.x; it < 256; it += F.G) {
        const int b = it >> 5, h = (it >> 3) & 3, vs = it & 7;
        float cwq[4][4], cwk[4][4], cbq[4], cbk[4];
#pragma unroll
        for (int e = 0; e < 4; ++e) { const int ch = 128 * h + 4 * kg + e;
            cbq[e] = IN_ML_CONV_B(A)[l * 1024 + ch]; cbk[e] = IN_ML_CONV_B(A)[l * 1024 + 512 + ch];
#pragma unroll
            for (int j = 0; j < 4; ++j) { cwq[j][e] = IN_ML_CONV_W(A)[l * 4096 + j * 1024 + ch]; cwk[j][e] = IN_ML_CONV_W(A)[l * 4096 + j * 1024 + 512 + ch]; } }
        float pq[3][4], pk[3][4];
#pragma unroll
        for (int j = 0; j < 3; ++j)
#pragma unroll
            for (int e = 0; e < 4; ++e) { pq[j][e] = 0.f; pk[j][e] = 0.f; }
        float C[4] = {0.f, 0.f, 0.f, 0.f}, n[4] = {0.f, 0.f, 0.f, 0.f}, mst = 0.f;
        const size_t rb = (size_t)b * SEQ;
        for (int t0 = 0; t0 < SEQ; t0 += 8) {
            typedef unsigned u32x2v __attribute__((ext_vector_type(2)));
            u32x2v rq[8], rk[8]; unsigned short rv[8]; float rig[8], rlf[8];
#pragma unroll
            for (int s = 0; s < 8; ++s) { const size_t row = rb + t0 + s;
                rq[s] = *(const u32x2v*)(MQ + row * 512 + 128 * h + 4 * kg); rk[s] = *(const u32x2v*)(MK + row * 512 + 128 * h + 4 * kg);
                rv[s] = MV[row * 512 + 128 * h + 16 * vs + vv]; rig[s] = IG[row * 4 + h]; rlf[s] = LF[row * 4 + h]; }
#pragma unroll
            for (int s = 0; s < 8; ++s) {
                float cq[4] = {bflo(rq[s].x), bfhi(rq[s].x), bflo(rq[s].y), bfhi(rq[s].y)}, ck[4] = {bflo(rk[s].x), bfhi(rk[s].x), bflo(rk[s].y), bfhi(rk[s].y)};
                float qv[4], kv[4];
#pragma unroll
                for (int e = 0; e < 4; ++e) {
                    float aq = cbq[e] + pq[0][e] * cwq[0][e] + pq[1][e] * cwq[1][e] + pq[2][e] * cwq[2][e] + cq[e] * cwq[3][e];
                    float ak = cbk[e] + pk[0][e] * cwk[0][e] + pk[1][e] * cwk[1][e] + pk[2][e] * cwk[2][e] + ck[e] * cwk[3][e];
                    qv[e] = aq * sigm(aq); kv[e] = ak * sigm(ak) * 0.08838834764831845f;
                    pq[0][e] = pq[1][e]; pq[1][e] = pq[2][e]; pq[2][e] = cq[e]; pk[0][e] = pk[1][e]; pk[1][e] = pk[2][e]; pk[2][e] = ck[e];
                }
                const float vt = bf2f(rv[s]), ig = rig[s], lf = rlf[s];
                const float mn = fmaxf(lf + mst, ig), fp = __expf(lf + mst - mn), ip = __expf(ig - mn);
                float num = 0.f, den = 0.f;
#pragma unroll
                for (int e = 0; e < 4; ++e) { C[e] = fp * C[e] + ip * vt * kv[e]; n[e] = fp * n[e] + ip * kv[e]; num += C[e] * qv[e]; den += n[e] * qv[e]; }
#pragma unroll
                for (int o = 1; o < 32; o <<= 1) { num += __shfl_xor(num, o); den += __shfl_xor(den, o); }
                mst = mn;
                if (kg == 0) HB[(rb + t0 + s) * 512 + 128 * h + 16 * vs + vv] = num / fmaxf(fabsf(den), __expf(-mn));
            }
        }
    }
}
__device__ __forceinline__ void mlfin_v1(Frame& F, const Args& A, int l) {
    int lane_ = (lane_id_now()); asm volatile("" : "+v"(lane_)); const int gw = F.vcu * NWAVES + F.wave, NGW = F.G * NWAVES, lane = lane_;
    const bf16* MO = (const bf16*)(F.ws + WS_MO); const bf16* MZ = (const bf16*)(F.ws + WS_MZ); const float* HB = (const float*)(F.ws + WS_HB); bf16* MIX = (bf16*)(F.ws + WS_MIX);
    for (int it = gw; it < M * 4; it += NGW) {
        const int m = it >> 2, h = it & 3;
        float v[2]; float q = 0.f;
#pragma unroll
        for (int k = 0; k < 2; ++k) { const size_t o = (size_t)m * 512 + 128 * h + lane + 64 * k; v[k] = bf2f(MO[o]) * HB[o]; q += v[k] * v[k]; }
        const float rstd = 1.0f / sqrtf(wave_sum(q) * (1.0f / 128.0f) + EPS);
#pragma unroll
        for (int k = 0; k < 2; ++k) { const int ch = 128 * h + lane + 64 * k;
            const float y = v[k] * rstd * IN_ML_OUT_G(A)[l * 512 + ch] * bf2f(MZ[(size_t)m * 512 + ch]);
            MIX[(size_t)m * 1024 + 256 + ch] = (bf16)f2bf(y); }
    }
}


typedef float f32x16 __attribute__((ext_vector_type(16)));
typedef unsigned u32x4 __attribute__((ext_vector_type(4)));
typedef short s16x4 __attribute__((ext_vector_type(4)));
typedef short v4i16_t __attribute__((ext_vector_type(4)));
typedef float f32x2_t __attribute__((ext_vector_type(2))); typedef __bf16 bf16x2_t __attribute__((ext_vector_type(2)));
typedef LAS const unsigned char* lds_cptr;
__device__ __forceinline__ int crow(int r, int hi) { return (r & 3) + 8 * (r >> 2) + 4 * hi; }
__device__ __forceinline__ unsigned cvtpk(float lo, float hi) { f32x2_t v = {lo, hi}; bf16x2_t b = __builtin_convertvector(v, bf16x2_t); return __builtin_bit_cast(unsigned, b); }
__device__ __forceinline__ s16x4 vtr(lds_cptr p) { return __builtin_bit_cast(s16x4, __builtin_amdgcn_ds_read_tr16_b64_v4i16((LAS v4i16_t*)p)); }
__device__ __forceinline__ bf16x8 mk8(s16x4 lo, s16x4 hi) { return (bf16x8){lo[0], lo[1], lo[2], lo[3], hi[0], hi[1], hi[2], hi[3]}; }
#define MFMA32(a, b, c) __builtin_amdgcn_mfma_f32_32x32x16_bf16((a), (b), (c), 0, 0, 0)

constexpr int AT_KSTR = 1040, AT_KHEAD = 8 * AT_KSTR, AT_KBUF = 4 * AT_KHEAD, AT_VHEAD = 8192, AT_VBUF = 4 * AT_VHEAD;
constexpr int AT_K0 = 0, AT_V0 = 2 * AT_KBUF, AT_END = AT_V0 + 2 * AT_VBUF;
constexpr int AT_TAB = AT_END, AT_TABH = 260, AT_WS = AT_TAB + 4 * AT_TABH * 4;
constexpr int AT_LDS_END = AT_WS + 8 * 256;
__device__ __forceinline__ void attn_phase(Frame& F, const Args& A, int l) {
    int tid_ = F.wave * 64 + lane_id_now(); asm volatile("" : "+v"(tid_));
    const int tid = tid_, lane = tid & 63, r32 = lane & 31, hi = lane >> 5, w = F.wave, hh = w >> 1, qh = w & 1;
    const bf16* AQ = (const bf16*)(F.ws + WS_AQ); const bf16* AK = (const bf16*)(F.ws + WS_AK); const bf16* AV = (const bf16*)(F.ws + WS_AV); const bf16* AZ = (const bf16*)(F.ws + WS_AZ);
    bf16* MIX = (bf16*)(F.ws + WS_MIX);
    LAS unsigned char* L = F.lds;
    LAS float* tab = (LAS float*)(L + AT_TAB);
    LAS float* wsf = (LAS float*)(L + AT_WS) + w * 64;
    {
        const float gq = fabsf(IN_ATT_Q_G(A)[l * 64 + lane]), gk = fabsf(IN_ATT_K_G(A)[l * 64 + lane]);
        const float mq = wave_max(gq), mk = wave_max(gk);
        const float* bsrc = IN_REL_BIAS(A) + (l * 4 + (w & 3)) * 257;
        float bm = 0.f;
        for (int i = lane; i < 257; i += 64) bm = fmaxf(bm, fabsf(bsrc[i]));
        bm = wave_max(bm);
        const float mb = 8.2f * mq * mk + bm;
        if (w < 4) for (int i = lane; i < 257; i += 64) tab[w * AT_TABH + i] = (bsrc[i] - mb) * 1.4426950408889634f;
    }
    __syncthreads();
    const int piece = tid & 31, krow = tid >> 5, ph = piece >> 3, pc = piece & 7;
    const int kdst = ph * AT_KHEAD + pc * AT_KSTR + krow * 16;
    const int vdst = ph * AT_VHEAD + (pc >> 2) * 4096 + (krow >> 4) * 1024 + (krow & 15) * 64 + (pc & 3) * 16;
    const int kfrag = hh * AT_KHEAD + hi * AT_KSTR + r32 * 16;
    const int vfrag = hh * AT_VHEAD + ((lane >> 4) & 1) * 32 + (lane & 3) * 8 + (4 * hi + ((lane & 15) >> 2)) * 64;
    const int gw_unit0 = F.vcu * 4;
    for (int ui = 0; ui < 4; ++ui) {
        int u = gw_unit0 + ui; if (F.G != 256) { u = F.vcu + ui * F.G; }
        if (u >= 1024) break;
        const int b = u >> 7, c = u & 127, j0 = (c >= 8) ? c - 8 : 0, nst = c - j0 + 1;
        const size_t rowq = (size_t)b * SEQ + 64 * c;
        u32x4 kst[4], vst[4];
        { const size_t rb = ((size_t)b * SEQ + 64 * j0 + krow) * 256 + piece * 8;
#pragma unroll
          for (int i = 0; i < 4; ++i) { kst[i] = *(const u32x4*)(AK + rb + (size_t)i * 16 * 256); vst[i] = *(const u32x4*)(AV + rb + (size_t)i * 16 * 256); } }
        bf16x8 qf[4];
#pragma unroll
        for (int s = 0; s < 4; ++s) qf[s] = *(const bf16x8*)(AQ + (rowq + 32 * qh + r32) * 256 + 64 * hh + 16 * s + 8 * hi);
#pragma unroll
        for (int i = 0; i < 4; ++i) { *(LAS u32x4*)(L + AT_K0 + kdst + i * 256) = kst[i]; *(LAS u32x4*)(L + AT_V0 + vdst + i * 1024) = vst[i]; }
        __syncthreads();
        f32x16 o0 = {}, o1 = {}; float lsum = 0.f;
        for (int st = 0; st < nst; ++st) {
            const int j = j0 + st, buf = st & 1, dl = c - j;
            const bool more = (st + 1 < nst);
            if (more) { const size_t rb = ((size_t)b * SEQ + 64 * (j + 1) + krow) * 256 + piece * 8;
#pragma unroll
                for (int i = 0; i < 4; ++i) { kst[i] = *(const u32x4*)(AK + rb + (size_t)i * 16 * 256); vst[i] = *(const u32x4*)(AV + rb + (size_t)i * 16 * 256); } }
            const lds_cptr kb = (lds_cptr)(L + AT_K0 + buf * AT_KBUF + kfrag);
            const lds_cptr vb = (lds_cptr)(L + AT_V0 + buf * AT_VBUF + vfrag);
            const float cst = (dl >= 3) ? tab[hh * AT_TABH + 256] : 0.f;
            f32x16 p0, p1;
#pragma unroll
            for (int r = 0; r < 16; ++r) { p0[r] = cst; p1[r] = cst; }
#pragma unroll
            for (int s = 0; s < 4; ++s) {
                const bf16x8 k0 = *(const LAS bf16x8*)(kb + s * 2 * AT_KSTR), k1 = *(const LAS bf16x8*)(kb + s * 2 * AT_KSTR + 512);
                p0 = MFMA32(k0, qf[s], p0); p1 = MFMA32(k1, qf[s], p1);
            }
            if (dl < 3) {
                const int base = 64 * dl + 32 * qh + r32 + 128 - 4 * hi;
#pragma unroll
                for (int r = 0; r < 16; ++r) { const int ik = (r & 3) + 8 * (r >> 2);
                    int i0 = base - ik; i0 = i0 > 256 ? 256 : i0; int i1 = base - ik - 32; i1 = i1 > 256 ? 256 : i1;
                    p0[r] += tab[hh * AT_TABH + i0]; p1[r] += tab[hh * AT_TABH + i1]; }
            }
            float sacc = 0.f;
#pragma unroll
            for (int r = 0; r < 16; ++r) { p0[r] = __builtin_amdgcn_exp2f(p0[r]); p1[r] = __builtin_amdgcn_exp2f(p1[r]); sacc += p0[r] + p1[r]; }
            lsum += sacc;
            u32x4 pw[4];
#pragma unroll
            for (int e = 0; e < 4; ++e) { pw[0][e] = cvtpk(p0[2 * e], p0[2 * e + 1]); pw[1][e] = cvtpk(p0[8 + 2 * e], p0[8 + 2 * e + 1]); pw[2][e] = cvtpk(p1[2 * e], p1[2 * e + 1]); pw[3][e] = cvtpk(p1[8 + 2 * e], p1[8 + 2 * e + 1]); }
#pragma unroll
            for (int kg = 0; kg < 4; ++kg) {
                const bf16x8 pa = __builtin_bit_cast(bf16x8, pw[kg]);
                const bf16x8 v0 = mk8(vtr(vb + kg * 1024), vtr(vb + kg * 1024 + 512));
                const bf16x8 v1 = mk8(vtr(vb + 4096 + kg * 1024), vtr(vb + 4096 + kg * 1024 + 512));
                o0 = MFMA32(pa, v0, o0); o1 = MFMA32(pa, v1, o1);
            }
            if (more) {
#pragma unroll
                for (int i = 0; i < 4; ++i) { *(LAS u32x4*)(L + AT_K0 + (buf ^ 1) * AT_KBUF + kdst + i * 256) = kst[i]; *(LAS u32x4*)(L + AT_V0 + (buf ^ 1) * AT_VBUF + vdst + i * 1024) = vst[i]; }
            }
            __syncthreads();
        }
        lsum = xl_sum32(lsum);
        if (hi == 0) wsf[r32] = 1.0f / lsum;
        asm volatile("s_waitcnt lgkmcnt(0)" ::: "memory");
        const size_t orow = rowq + 32 * qh;
#pragma unroll
        for (int r = 0; r < 16; ++r) { const int q = crow(r, hi); const float inv = wsf[q];
            const size_t gi = (orow + q) * 256 + 64 * hh + r32, mi = (orow + q) * 1024 + 64 * hh + r32;
            const float y0 = o0[r] * inv * bf2f(AZ[gi]), y1 = o1[r] * inv * bf2f(AZ[gi + 32]);
            MIX[mi] = (bf16)f2bf(y0); MIX[mi + 32] = (bf16)f2bf(y1); }
        asm volatile("s_waitcnt lgkmcnt(0)" ::: "memory");
    }
    __syncthreads();
}


#ifndef MLSTM_G
#define MLSTM_G 8
#endif
constexpr int MG = MLSTM_G, MNT = 64 * MG, MNSC = SEQ / MNT, MUNITS = BATCH * 4 * MNSC;
static_assert(MG == 4 || MG == 8, "super-chunk = 4 or 8 chunks");
constexpr size_t WS_UB = 32 * MiB;
constexpr size_t WS_CS = 96 * MiB;
constexpr size_t WS_NB = 29 * MiB, WS_NS = 30 * MiB;
constexpr size_t WS_KC = 128 * MiB, WS_QC = 192 * MiB;
constexpr size_t WS_SB = 31 * MiB, WS_MS = 31 * MiB + 65536;
constexpr float LOG2E = 1.4426950408889634f;
template <class T> __device__ __forceinline__ T opq(T p) { asm volatile("" : "+v"(p)); return p; }
constexpr int ML_KSTR = 1040, ML_KBSZ = 16 * ML_KSTR;
constexpr int ML_KB = 0, ML_VB = 2 * ML_KBSZ, ML_CB = ML_VB + 2 * 16384, ML_GT = ML_CB + 128 * 272, ML_NS = ML_GT + 3 * MNT * 4, ML_CW = ML_NS + 512, ML_SC = ML_CW + 5120, ML_NA = ML_SC + 64, ML_WS = ML_NA + 512, ML_END = ML_WS + 2048;
static_assert(ML_END <= LDSCTL_OFF, "mLSTM LDS map");

__device__ __forceinline__ void gate_scan(LAS unsigned char* L, const float* LF, const float* IG, size_t R0, int h, float m_start, bool use_ms, int w, int lane, float& A_tot, float& gmax) {
    LAS float* scr = opq((LAS float*)(L + ML_SC)); LAS float* gt = opq((LAS float*)(L + ML_GT));
    float lf = 0.f, ig = 0.f;
    if (w < MG) { lf = LF[(R0 + 64 * w + lane) * 4 + h]; ig = IG[(R0 + 64 * w + lane) * 4 + h]; }
    float x = lf;
#pragma unroll
    for (int o = 1; o < 64; o <<= 1) { const float y = xl_up(x, lane, o); if (lane >= o) x += y; }
    if (w < MG && lane == 63) scr[w] = x;
    __syncthreads();
    float off = 0.f, tot = 0.f;
#pragma unroll
    for (int i = 0; i < MG; ++i) { const float v = scr[i]; tot += v; if (i < w) off += v; }
    const float Bp = x + off, g = ig - Bp;
    float pm = g;
#pragma unroll
    for (int o = 1; o < 64; o <<= 1) { const float y = xl_up(pm, lane, o); if (lane >= o) pm = fmaxf(pm, y); }
    if (w < MG && lane == 63) scr[8 + w] = pm;
    __syncthreads();
    float pmo = -3.0e38f, gm = -3.0e38f;
#pragma unroll
    for (int i = 0; i < MG; ++i) { const float v = scr[8 + i]; gm = fmaxf(gm, v); if (i < w) pmo = fmaxf(pmo, v); }
    pm = fmaxf(pm, pmo); if (use_ms) pm = fmaxf(pm, m_start);
    if (w < MG) { gt[64 * w + lane] = Bp * LOG2E; gt[MNT + 64 * w + lane] = g * LOG2E; gt[2 * MNT + 64 * w + lane] = pm * LOG2E; }
    A_tot = tot; gmax = gm;
    __syncthreads();
}
__device__ __forceinline__ void unpack8(u32x4 w, float* f) { f[0] = bflo(w.x); f[1] = bfhi(w.x); f[2] = bflo(w.y); f[3] = bfhi(w.y); f[4] = bflo(w.z); f[5] = bfhi(w.z); f[6] = bflo(w.w); f[7] = bfhi(w.w); }
__device__ __forceinline__ u32x4 pack8(const float* f) { u32x4 w; w.x = cvtpk(f[0], f[1]); w.y = cvtpk(f[2], f[3]); w.z = cvtpk(f[4], f[5]); w.w = cvtpk(f[6], f[7]); return w; }
__device__ __forceinline__ float silu_f(float a) { return a * __builtin_amdgcn_rcpf(1.0f + __builtin_amdgcn_exp2f(-LOG2E * a)); }
__device__ __forceinline__ void load_conv_tab(LAS unsigned char* L, const Args& A, int l, int h, int tid) {
    LAS float* cw = opq((LAS float*)(L + ML_CW));
    if (tid < 128) {
#pragma unroll
        for (int tap = 0; tap < 4; ++tap) { cw[tap * 128 + tid] = IN_ML_CONV_W(A)[l * 4096 + tap * 1024 + 128 * h + tid]; cw[640 + tap * 128 + tid] = IN_ML_CONV_W(A)[l * 4096 + tap * 1024 + 512 + 128 * h + tid]; }
        cw[512 + tid] = IN_ML_CONV_B(A)[l * 1024 + 128 * h + tid]; cw[1152 + tid] = IN_ML_CONV_B(A)[l * 1024 + 512 + 128 * h + tid];
    }
}
__device__ __forceinline__ void conv8(const u32x4 (&raw)[4], const LAS float* wt, const LAS float* bt, int col0, float* out) {
    const f32x4 b0 = *(const LAS f32x4*)(bt + col0), b1 = *(const LAS f32x4*)(bt + col0 + 4);
    float a[8] = {b0[0], b0[1], b0[2], b0[3], b1[0], b1[1], b1[2], b1[3]};
#pragma unroll
    for (int tap = 0; tap < 4; ++tap) { float x[8]; unpack8(raw[tap], x);
        const f32x4 w0 = *(const LAS f32x4*)(wt + tap * 128 + col0), w1 = *(const LAS f32x4*)(wt + tap * 128 + col0 + 4);
        a[0] += x[0] * w0[0]; a[1] += x[1] * w0[1]; a[2] += x[2] * w0[2]; a[3] += x[3] * w0[3]; a[4] += x[4] * w1[0]; a[5] += x[5] * w1[1]; a[6] += x[6] * w1[2]; a[7] += x[7] * w1[3]; }
#pragma unroll
    for (int e = 0; e < 8; ++e) out[e] = silu_f(a[e]);
}
__device__ __forceinline__ void load_raw4_fast(const char* base, unsigned off3, u32x4 (&raw)[4]) {
    const char* p = base + (size_t)off3;
#pragma unroll
    for (int tap = 0; tap < 4; ++tap) raw[tap] = *(const u32x4*)(p + tap * 1024);
}
__device__ __forceinline__ void load_raw4_edge(const char* base, unsigned off, int tpos, u32x4 (&raw)[4]) {
#pragma unroll
    for (int tap = 0; tap < 4; ++tap) { const bool ok = (tpos - 3 + tap) >= 0; const unsigned o = ok ? off - (unsigned)(3 - tap) * 1024u : off;
        const u32x4 v = *(const u32x4*)(base + (size_t)o); raw[tap] = ok ? v : (u32x4){0u, 0u, 0u, 0u}; }
}

__device__ __forceinline__ void ml_b1(Frame& F, const Args& A, int l) {
    int tid_ = F.wave * 64 + lane_id_now(); asm volatile("" : "+v"(tid_));
    const int tid = tid_, lane = tid & 63, r32 = lane & 31, hi = lane >> 5, w = F.wave;
    const bf16* MQ = (const bf16*)(F.ws + WS_MQ); const bf16* MK = (const bf16*)(F.ws + WS_MK); const bf16* MV = (const bf16*)(F.ws + WS_MV);
    bf16* KC = (bf16*)(F.ws + WS_KC); bf16* QC = (bf16*)(F.ws + WS_QC);
    const float* LF = (const float*)(F.ws + WS_LF); const float* IG = (const float*)(F.ws + WS_IG);
    float* UB = (float*)(F.ws + WS_UB); float* NB = (float*)(F.ws + WS_NB); float* SB = (float*)(F.ws + WS_SB);
    LAS unsigned char* L = F.lds; LAS float* gt = opq((LAS float*)(L + ML_GT)); LAS float* cw = opq((LAS float*)(L + ML_CW)); LAS float* nacc = opq((LAS float*)(L + ML_NA));
    const int cseg = tid & 15, krow = tid >> 4;
    const int sdst = (cseg >> 2) * 4096 + (krow >> 4) * 1024 + (krow & 15) * 64 + (cseg & 3) * 16;
    const int trl = ((lane >> 4) & 1) * 32 + (lane & 3) * 8 + (4 * hi + ((lane & 15) >> 2)) * 64;
    const int dvt = w >> 1, dkt0 = 2 * (w & 1);
    for (int unit = F.vcu; unit < MUNITS; unit += F.G) {
        const int b = unit / (4 * MNSC), h = (unit / MNSC) & 3, sc = unit % MNSC;
        const size_t R0 = (size_t)b * SEQ + (size_t)sc * MNT;
        load_conv_tab(L, A, l, h, tid);
        if (tid < 128) nacc[tid] = 0.f;
        float A_tot, gmax;
        gate_scan(L, LF, IG, R0, h, 0.f, false, w, lane, A_tot, gmax);
        const float gm2 = gmax * LOG2E;
        f32x16 acc0 = {}, acc1 = {}; float nsum[8] = {0.f, 0.f, 0.f, 0.f, 0.f, 0.f, 0.f, 0.f};
        u32x4 rk[2][4], rq[2][4], rv[2];
        const unsigned koff0 = (unsigned)(((R0 + krow) * 512 + 128 * h + 8 * cseg) * 2);
#define B1_LOAD(j) do { const unsigned ob = opq(koff0 + (unsigned)(j) * 65536u); \
            if (sc == 0 && (j) == 0 && w == 0) { load_raw4_edge((const char*)MK, ob, krow, rk[0]); load_raw4_edge((const char*)MQ, ob, krow, rq[0]); } \
            else { load_raw4_fast((const char*)MK, ob - 3072u, rk[0]); load_raw4_fast((const char*)MQ, ob - 3072u, rq[0]); } \
            load_raw4_fast((const char*)MK, ob + 32768u - 3072u, rk[1]); load_raw4_fast((const char*)MQ, ob + 32768u - 3072u, rq[1]); \
            rv[0] = *(const u32x4*)((const char*)MV + (size_t)ob); rv[1] = *(const u32x4*)((const char*)MV + (size_t)ob + 32768); } while (0)
#define B1_WRITE(j, buf) do { _Pragma("unroll") for (int i = 0; i < 2; ++i) { const int t = 64 * (j) + krow + 32 * i; \
            float kf[8], vf[8]; conv8(rk[i], cw + 640, cw + 1152, 8 * cseg, kf); const float wk = __builtin_amdgcn_exp2f(gt[MNT + t] - gm2); unpack8(rv[i], vf); \
            _Pragma("unroll") for (int e = 0; e < 8; ++e) { kf[e] *= 0.08838834764831845f; nsum[e] += wk * kf[e]; vf[e] *= wk; } \
            const u32x4 kpk = pack8(kf); const size_t go = (size_t)opq(koff0 + (unsigned)(j) * 65536u + (unsigned)i * 32768u); \
            *(LAS u32x4*)(L + ML_KB + (buf) * ML_KBSZ + sdst + i * 2048) = kpk; *(LAS u32x4*)(L + ML_VB + (buf) * 16384 + sdst + i * 2048) = pack8(vf); \
            *(u32x4*)((char*)KC + go) = kpk; conv8(rq[i], cw, cw + 512, 8 * cseg, kf); *(u32x4*)((char*)QC + go) = pack8(kf); } } while (0)
        B1_LOAD(0); B1_WRITE(0, 0);
        __syncthreads();
        for (int j = 0; j < MG; ++j) {
            const int buf = j & 1; const bool more = (j + 1 < MG);
            if (more) B1_LOAD(j + 1);
            const lds_cptr ab = opq((lds_cptr)(L + ML_VB + buf * 16384 + dvt * 4096 + trl));
            const lds_cptr bb = opq((lds_cptr)(L + ML_KB + buf * ML_KBSZ + dkt0 * 4096 + trl));
#pragma unroll
            for (int kg = 0; kg < 4; ++kg) {
                const bf16x8 af = mk8(vtr(ab + kg * 1024), vtr(ab + kg * 1024 + 512));
                const bf16x8 b0 = mk8(vtr(bb + kg * 1024), vtr(bb + kg * 1024 + 512));
                const bf16x8 b1 = mk8(vtr(bb + 4096 + kg * 1024), vtr(bb + 4096 + kg * 1024 + 512));
                acc0 = MFMA32(af, b0, acc0); acc1 = MFMA32(af, b1, acc1);
            }
            if (more) B1_WRITE(j + 1, buf ^ 1);
            __syncthreads();
        }
#undef B1_LOAD
#undef B1_WRITE
        float* U = UB + (size_t)unit * 16384;
#pragma unroll
        for (int r = 0; r < 16; ++r) { const int dv = 32 * dvt + crow(r, hi); U[dv * 128 + 32 * dkt0 + r32] = acc0[r]; U[dv * 128 + 32 * dkt0 + 32 + r32] = acc1[r]; }
#pragma unroll
        for (int e = 0; e < 8; ++e) { float v = nsum[e]; v += xl_xor<16>(v); v = xl_sum32(v); if (lane < 16) __hip_atomic_fetch_add(nacc + 8 * cseg + e, v, __ATOMIC_RELAXED, __HIP_MEMORY_SCOPE_WORKGROUP); }
        __syncthreads();
        if (tid < 128) NB[(size_t)unit * 128 + tid] = nacc[tid];
        if (tid == 0) { SB[unit * 2] = A_tot; SB[unit * 2 + 1] = A_tot + gmax; }
        __syncthreads();
    }
}

__device__ __forceinline__ void ml_b2(Frame& F) {
    int tid_ = F.wave * 64 + lane_id_now(); asm volatile("" : "+v"(tid_));
    const int tid = tid_;
    const float* UB = (const float*)(F.ws + WS_UB); const float* NB = (const float*)(F.ws + WS_NB); const float* SB = (const float*)(F.ws + WS_SB);
    bf16* CS = (bf16*)(F.ws + WS_CS); float* NS = (float*)(F.ws + WS_NS); float* MS = (float*)(F.ws + WS_MS);
    typedef unsigned u32x2v __attribute__((ext_vector_type(2)));
    for (int it = F.vcu; it < 256; it += F.G) {
        const int bh = it >> 3, slice = it & 7; const int e0 = slice * 2048 + tid * 4;
        const bool nown = (slice == 0 && tid < 32);
        f32x4 C = {0.f, 0.f, 0.f, 0.f}, n = {0.f, 0.f, 0.f, 0.f}; float m = 0.f;
#pragma unroll 4
        for (int sc = 0; sc < MNSC; ++sc) {
            const int unit = bh * MNSC + sc;
            u32x2v cw2; cw2.x = cvtpk(C[0], C[1]); cw2.y = cvtpk(C[2], C[3]);
            *(u32x2v*)(CS + (size_t)unit * 16384 + e0) = cw2;
            if (nown) *(f32x4*)(NS + (size_t)unit * 128 + 4 * tid) = n;
            if (slice == 0 && tid == 0) MS[unit] = m;
            const float At = SB[unit * 2], mu = SB[unit * 2 + 1];
            const float mn = fmaxf(At + m, mu), a = __expf(At + m - mn), bb = __expf(mu - mn);
            const f32x4 U4 = *(const f32x4*)(UB + (size_t)unit * 16384 + e0);
            C = C * a + U4 * bb;
            if (nown) { const f32x4 n4 = *(const f32x4*)(NB + (size_t)unit * 128 + 4 * tid); n = n * a + n4 * bb; }
            m = mn;
        }
    }
}

__device__ __forceinline__ void ml_b3(Frame& F, const Args& A, int l) {
    int tid_ = F.wave * 64 + lane_id_now(); asm volatile("" : "+v"(tid_));
    const int tid = tid_, lane = tid & 63, r32 = lane & 31, hi = lane >> 5, w = F.wave;
    const bf16* QC = (const bf16*)(F.ws + WS_QC); const bf16* KC = (const bf16*)(F.ws + WS_KC); const bf16* MV = (const bf16*)(F.ws + WS_MV);
    const bf16* MO = (const bf16*)(F.ws + WS_MO); const bf16* MZ = (const bf16*)(F.ws + WS_MZ); bf16* MIX = (bf16*)(F.ws + WS_MIX);
    const float* LF = (const float*)(F.ws + WS_LF); const float* IG = (const float*)(F.ws + WS_IG);
    const bf16* CS = (const bf16*)(F.ws + WS_CS); const float* NS = (const float*)(F.ws + WS_NS); const float* MS = (const float*)(F.ws + WS_MS);
    LAS unsigned char* L = F.lds; LAS float* gt = opq((LAS float*)(L + ML_GT)); LAS float* gl = opq((LAS float*)(L + ML_CW)); LAS float* nsl = opq((LAS float*)(L + ML_NS));
    LAS float* wsf = opq((LAS float*)(L + ML_WS) + w * 64);
    const int cseg = tid & 15, krow = tid >> 4;
    const int kdst = cseg * ML_KSTR + krow * 16;
    const int vdst = (cseg >> 2) * 4096 + (krow >> 4) * 1024 + (krow & 15) * 64 + (cseg & 3) * 16;
    const int trl = ((lane >> 4) & 1) * 32 + (lane & 3) * 8 + (4 * hi + ((lane & 15) >> 2)) * 64;
    const int kfrag = hi * ML_KSTR + r32 * 16;
    const int qh = w & 1;
    for (int unit = F.vcu; unit < MUNITS; unit += F.G) {
        const int b = unit / (4 * MNSC), h = (unit / MNSC) & 3, sc = unit % MNSC;
        const size_t R0 = (size_t)b * SEQ + (size_t)sc * MNT;
        const float m_start = MS[unit], ms2 = m_start * LOG2E;
        if (tid < 128) { nsl[tid] = NS[(size_t)unit * 128 + tid]; gl[tid] = IN_ML_OUT_G(A)[l * 512 + 128 * h + tid]; }
#pragma unroll
        for (int i = 0; i < 4; ++i) { const int p = tid + 512 * i; *(LAS u32x4*)(L + ML_CB + (p >> 4) * 272 + (p & 15) * 16) = *(const u32x4*)(CS + (size_t)unit * 16384 + (size_t)p * 8); }
        float A_tot, gmax;
        gate_scan(L, LF, IG, R0, h, m_start, true, w, lane, A_tot, gmax);
        const unsigned kdma = (unsigned)(((R0 + lane) * 512 + 128 * h + 16 * w) * 2);
        const unsigned vdma = (unsigned)(((R0 + 16 * ((2 * w) & 3) + (lane >> 2)) * 512 + 128 * h + 32 * (w >> 1) + 8 * (lane & 3)) * 2);
#define B3_DMA(j, buf) do { const size_t ko = (size_t)opq(kdma + (unsigned)(j) * 65536u), vo = (size_t)opq(vdma + (unsigned)(j) * 65536u); \
            __builtin_amdgcn_global_load_lds((const unsigned*)((const char*)KC + ko), (LAS unsigned*)(L + ML_KB + (buf) * ML_KBSZ + (2 * w) * ML_KSTR), 16, 0, 0); \
            __builtin_amdgcn_global_load_lds((const unsigned*)((const char*)KC + ko + 16), (LAS unsigned*)(L + ML_KB + (buf) * ML_KBSZ + (2 * w + 1) * ML_KSTR), 16, 0, 0); \
            __builtin_amdgcn_global_load_lds((const unsigned*)((const char*)MV + vo), (LAS unsigned*)(L + ML_VB + (buf) * 16384 + (w >> 1) * 4096 + ((2 * w) & 3) * 1024), 16, 0, 0); \
            __builtin_amdgcn_global_load_lds((const unsigned*)((const char*)MV + vo + 16384), (LAS unsigned*)(L + ML_VB + (buf) * 16384 + (w >> 1) * 4096 + ((2 * w + 1) & 3) * 1024), 16, 0, 0); } while (0)
#define B3_QK(j, buf) do { \
            const lds_cptr kb = opq((lds_cptr)(L + ML_KB + (buf) * ML_KBSZ + kfrag)); \
            f32x16 p0 = {}, p1 = {}; \
            _Pragma("unroll") for (int s = 0; s < 8; ++s) { \
                const bf16x8 k0 = *(const LAS bf16x8*)(kb + s * 2 * ML_KSTR), k1 = *(const LAS bf16x8*)(kb + s * 2 * ML_KSTR + 512); \
                p0 = MFMA32(k0, qf[s], p0); p1 = MFMA32(k1, qf[s], p1); \
                if (s & 1) __builtin_amdgcn_sched_barrier(0); } \
            const LAS float* gk = opq(gt + MNT + 64 * (j) + 4 * hi); \
            const int iqo = ((j) == c) ? opq(32 * qh + r32 - 4 * hi) : 1000; \
            float sacc = 0.f; \
            _Pragma("unroll") for (int r4 = 0; r4 < 4; ++r4) { \
                const f32x4 g0 = *(const LAS f32x4*)(gk + 8 * r4), g1 = *(const LAS f32x4*)(gk + 32 + 8 * r4); \
                _Pragma("unroll") for (int e = 0; e < 4; ++e) { const int r = 4 * r4 + e, ikr = 8 * r4 + e; \
                    float d0 = __builtin_amdgcn_exp2f(g0[e] - Mq), d1 = __builtin_amdgcn_exp2f(g1[e] - Mq); \
                    d0 = (ikr > iqo) ? 0.f : d0; d1 = (ikr + 32 > iqo) ? 0.f : d1; \
                    p0[r] *= d0; p1[r] *= d1; sacc += p0[r] + p1[r]; } } \
            den += sacc; \
            _Pragma("unroll") for (int e = 0; e < 4; ++e) { pw[0][e] = cvtpk(p0[2 * e], p0[2 * e + 1]); pw[1][e] = cvtpk(p0[8 + 2 * e], p0[8 + 2 * e + 1]); pw[2][e] = cvtpk(p1[2 * e], p1[2 * e + 1]); pw[3][e] = cvtpk(p1[8 + 2 * e], p1[8 + 2 * e + 1]); } \
        } while (0)
#define B3_PV(buf) do { \
            const lds_cptr vb = opq((lds_cptr)(L + ML_VB + (buf) * 16384 + trl)); \
            _Pragma("unroll") for (int kg = 0; kg < 4; ++kg) { \
                const bf16x8 pa = __builtin_bit_cast(bf16x8, pw[kg]); \
                o0 = MFMA32(pa, mk8(vtr(vb + kg * 1024), vtr(vb + kg * 1024 + 512)), o0); \
                o1 = MFMA32(pa, mk8(vtr(vb + 4096 + kg * 1024), vtr(vb + 4096 + kg * 1024 + 512)), o1); \
                o2 = MFMA32(pa, mk8(vtr(vb + 8192 + kg * 1024), vtr(vb + 8192 + kg * 1024 + 512)), o2); \
                o3 = MFMA32(pa, mk8(vtr(vb + 12288 + kg * 1024), vtr(vb + 12288 + kg * 1024 + 512)), o3); \
                __builtin_amdgcn_sched_barrier(0); } } while (0)
#pragma unroll 1
        for (int pass = 0; pass < MG / 4; ++pass) {
            const int c = (pass == 0) ? (w >> 1) : (MG - 1 - (w >> 1)), jmax = (pass == 0) ? 3 : (MG - 1);
            const int tq = 64 * c + 32 * qh + r32;
            B3_DMA(0, 0);
            bf16x8 qf[8]; float dn = 0.f;
            f32x16 o0 = {}, o1 = {}, o2 = {}, o3 = {};
            const lds_cptr cb0 = opq((lds_cptr)(L + ML_CB + r32 * 272 + 16 * hi));
            const float Mq = gt[2 * MNT + tq], wint = __builtin_amdgcn_exp2f(ms2 - Mq);
            const unsigned qoff = opq((unsigned)(((R0 + tq) * 512 + 128 * h + 8 * hi) * 2));
#pragma unroll
            for (int s = 0; s < 8; ++s) {
                qf[s] = *(const bf16x8*)((const char*)QC + (size_t)qoff + 32 * s);
                float q[8]; unpack8(__builtin_bit_cast(u32x4, qf[s]), q);
                const f32x4 n0 = *(const LAS f32x4*)(nsl + 16 * s + 8 * hi), n1 = *(const LAS f32x4*)(nsl + 16 * s + 8 * hi + 4);
                dn += (q[0] * n0[0] + q[1] * n0[1]) + (q[2] * n0[2] + q[3] * n0[3]) + (q[4] * n1[0] + q[5] * n1[1]) + (q[6] * n1[2] + q[7] * n1[3]);
                float qs[8];
#pragma unroll
                for (int e = 0; e < 8; ++e) qs[e] = q[e] * wint;
                const bf16x8 qw = __builtin_bit_cast(bf16x8, pack8(qs));
                const lds_cptr cb = cb0 + 32 * s;
                o0 = MFMA32(qw, *(const LAS bf16x8*)(cb), o0); o1 = MFMA32(qw, *(const LAS bf16x8*)(cb + 32 * 272), o1);
                o2 = MFMA32(qw, *(const LAS bf16x8*)(cb + 64 * 272), o2); o3 = MFMA32(qw, *(const LAS bf16x8*)(cb + 96 * 272), o3);
                if (s & 1) __builtin_amdgcn_sched_barrier(0);
            }
            dn = xl_sum32(dn);
            float den = 0.f;
            __syncthreads();
            for (int j = 0; j <= jmax; ++j) {
                const int buf = j & 1;
                u32x4 pw[4];
                if (j < jmax) B3_DMA(j + 1, buf ^ 1);
                if (j <= c) { B3_QK(j, buf); B3_PV(buf); }
                __syncthreads();
            }
            den = xl_sum32(den);
            den += wint * dn;
            const float mt2 = gt[tq] + Mq;
            const float dd = fmaxf(fabsf(den), __builtin_amdgcn_exp2f(-mt2));
            if (hi == 0) wsf[r32] = 1.0f / dd;
            asm volatile("s_waitcnt lgkmcnt(0)" ::: "memory");
            LAS unsigned short* tb = opq((LAS unsigned short*)(L + ML_KB + w * 8192) + r32 + 4 * hi * 128);
#pragma unroll
            for (int r = 0; r < 16; ++r) { const float inv = wsf[crow(r, hi)]; LAS unsigned short* tp = tb + ((r & 3) + 8 * (r >> 2)) * 128;
                tp[0] = (unsigned short)f2bf(o0[r] * inv); tp[32] = (unsigned short)f2bf(o1[r] * inv); tp[64] = (unsigned short)f2bf(o2[r] * inv); tp[96] = (unsigned short)f2bf(o3[r] * inv); }
            asm volatile("s_waitcnt lgkmcnt(0)" ::: "memory");
            {
                const int row = lane >> 1, half = lane & 1;
                const size_t tok = R0 + 64 * c + 32 * qh + row;
                const char* mop = (const char*)MO + (tok * 512 + 128 * h) * 2; const char* mzp = (const char*)MZ + (tok * 512 + 128 * h) * 2;
                char* mxp = (char*)MIX + (tok * 1024 + 256 + 128 * h) * 2;
                const LAS unsigned char* trow = opq((const LAS unsigned char*)(L + ML_KB + w * 8192 + row * 256));
                float y[8][8]; float ssq = 0.f;
#pragma unroll
                for (int k = 0; k < 8; ++k) { const int ci = half * 8 + ((k + row) & 7);
                    float hv[8], mo[8]; unpack8(*(const LAS u32x4*)(trow + ci * 16), hv); unpack8(*(const u32x4*)(mop + ci * 16), mo);
#pragma unroll
                    for (int e = 0; e < 8; ++e) { y[k][e] = hv[e] * mo[e]; ssq += y[k][e] * y[k][e]; } }
                ssq += xl_xor<1>(ssq);
                const float rstd = 1.0f / sqrtf(ssq * (1.0f / 128.0f) + EPS);
#pragma unroll
                for (int k = 0; k < 8; ++k) { const int ci = half * 8 + ((k + row) & 7);
                    float mz[8]; unpack8(*(const u32x4*)(mzp + ci * 16), mz);
                    const f32x4 ga = *(const LAS f32x4*)(gl + 8 * ci), gb = *(const LAS f32x4*)(gl + 8 * ci + 4);
                    float o8[8];
#pragma unroll
                    for (int e = 0; e < 8; ++e) o8[e] = y[k][e] * rstd * (e < 4 ? ga[e] : gb[e - 4]) * mz[e];
                    *(u32x4*)(mxp + ci * 16) = pack8(o8); }
            }
            __syncthreads();
        }
#undef B3_DMA
#undef B3_QK
#undef B3_PV
    }
}


constexpr int CV_UT = 0, CV_ROWS = 94, CV_YT = CV_ROWS * 512, CV_END = CV_YT + 64 * 1024;
static_assert(CV_END <= LDSCTL_OFF, "conv LDS map");
__device__ __forceinline__ void conv_phase(Frame& F, const Args& A, int l) {
    int tid_ = F.wave * 64 + lane_id_now(); asm volatile("" : "+v"(tid_));
    const int tid = tid_, lane = tid & 63, w = F.wave;
    const bf16* CU = (const bf16*)(F.ws + WS_CU); const bf16* CZ = (const bf16*)(F.ws + WS_CZ); bf16* MIX = (bf16*)(F.ws + WS_MIX);
    LAS unsigned char* L = F.lds;
    const int ch = tid & 255, th = tid >> 8;
    float wj[31];
#pragma unroll
    for (int j = 0; j < 31; ++j) wj[j] = IN_CV_DW_W(A)[l * 31 * 256 + j * 256 + ch];
    const float cbias = IN_CV_DW_B(A)[l * 256 + ch];
    const f32x4 g4 = *(const f32x4*)(IN_CV_LN_G(A) + l * 256 + 4 * lane), b4 = *(const f32x4*)(IN_CV_LN_B(A) + l * 256 + 4 * lane);
    typedef unsigned u32x2v __attribute__((ext_vector_type(2)));
    const int nun = (F.G == 256) ? 4 : (1024 + F.G - 1) / F.G;
    u32x4 nx[6];
#define CV_UNIT(ui) ((F.G == 256) ? F.vcu * 4 + (ui) : F.vcu + (ui) * F.G)
#define CV_LOAD(u) do { const int b_ = (u) >> 7, t0_ = ((u) & 127) * 64; _Pragma("unroll") for (int i = 0; i < 6; ++i) { const int p = tid + 512 * i, row = p >> 5, pc = p & 31, tr = t0_ - 30 + row; \
        nx[i] = (p < CV_ROWS * 32 && tr >= 0) ? *(const u32x4*)(CU + ((size_t)b_ * SEQ + tr) * 256 + pc * 8) : (u32x4){0u, 0u, 0u, 0u}; } } while (0)
#define CV_STORE() do { _Pragma("unroll") for (int i = 0; i < 6; ++i) { const int p = tid + 512 * i; if (p < CV_ROWS * 32) *(LAS u32x4*)(L + CV_UT + p * 16) = nx[i]; } } while (0)
    if (CV_UNIT(0) < 1024) { CV_LOAD(CV_UNIT(0)); CV_STORE(); }
    __syncthreads();
    for (int ui = 0; ui < nun; ++ui) {
        const int u = CV_UNIT(ui); if (u >= 1024) break;
        const int un = CV_UNIT(ui + 1); const bool more = (ui + 1 < nun) && (un < 1024);
        if (more) CV_LOAD(un);
        {
            const LAS unsigned short* up = opq((const LAS unsigned short*)(L + CV_UT + (32 * th) * 512 + ch * 2));
            float uv[62];
#pragma unroll
            for (int r = 0; r < 62; ++r) uv[r] = bf2f(up[r * 256]);
            float acc[32];
#pragma unroll
            for (int i = 0; i < 32; ++i) { float a = cbias;
#pragma unroll
                for (int j = 0; j < 31; ++j) a += uv[i + j] * wj[j];
                acc[i] = a; }
            LAS float* yp = opq((LAS float*)(L + CV_YT + (32 * th) * 1024 + ch * 4));
#pragma unroll
            for (int i = 0; i < 32; ++i) yp[i * 256] = acc[i];
        }
        __syncthreads();
        if (more) CV_STORE();
        {
            const int b = u >> 7, t0 = (u & 127) * 64;
            const LAS f32x4* yr = opq((const LAS f32x4*)(L + CV_YT + (8 * w) * 1024 + lane * 16));
            const size_t row0 = (size_t)b * SEQ + t0 + 8 * w;
#pragma unroll
            for (int k = 0; k < 8; ++k) {
                f32x4 y = yr[k * 64];
                const float mean = wave_sum((y[0] + y[1]) + (y[2] + y[3])) * (1.0f / 256.0f);
                y = y - mean;
                const float rstd = 1.0f / sqrtf(wave_sum((y[0] * y[0] + y[1] * y[1]) + (y[2] * y[2] + y[3] * y[3])) * (1.0f / 256.0f) + EPS);
                y = y * rstd * g4 + b4;
                const u32x2v cz = *(const u32x2v*)(CZ + (row0 + k) * 256 + 4 * lane);
                const float o0 = y[0] * pg8::sigmoid_f(y[0]) * bflo(cz.x), o1 = y[1] * pg8::sigmoid_f(y[1]) * bfhi(cz.x), o2 = y[2] * pg8::sigmoid_f(y[2]) * bflo(cz.y), o3 = y[3] * pg8::sigmoid_f(y[3]) * bfhi(cz.y);
                u32x2v ow; ow.x = cvtpk(o0, o1); ow.y = cvtpk(o2, o3);
                *(u32x2v*)(MIX + (row0 + k) * 1024 + 768 + 4 * lane) = ow;
            }
        }
        __syncthreads();
    }
#undef CV_UNIT
#undef CV_LOAD
#undef CV_STORE
}

__global__ void __launch_bounds__(NWAVES * 64, 2) skel_fwd(Args args) {
    extern __shared__ __attribute__((aligned(16))) unsigned char lds[];
    Frame F;
    F.lds = (LAS unsigned char*)lds;
    F.MISC = (volatile LAS unsigned*)(F.lds + MISC_OFF);
    F.wave = __builtin_amdgcn_readfirstlane((int)(threadIdx.x >> 6));
    F.G = gridDim.x; { const int bx = blockIdx.x; F.vcu = (F.G % 8 == 0) ? (bx % 8) * (F.G / 8) + bx / 8 : bx; }
    unsigned char* ws = args.ws; F.ws = ws;
    F.ctl = (gu32*)(ws + WS_CTL);
    for (int u = ((int)threadIdx.x); u < (LDS_BYTES - LDSCTL_OFF) / 4; u += NWAVES * 64) ((LAS unsigned*)(F.lds + LDSCTL_OFF))[u] = 0u;
    __syncthreads();
    XcdBarrier bar; bar.bar = (unsigned*)(F.ctl + CW_BAR); bar.x = 0; bar.st = nullptr;
    if (N_LAUNCHES == 1) bar = xcd_barrier_post((unsigned*)(F.ctl + CW_BAR), F.MISC + 8);
#define GRID_BAR() do { if (N_LAUNCHES == 1) xcd_barrier(bar); } while (0)
    const int lo = args.ph_lo, hi = args.ph_hi;
#define IN(k) (lo <= (k) && (k) < hi)
#define BOTH(k) (IN(k) && IN((k) + 1))
    if (IN(0)) { p0_prologue(F, args); if (BOTH(0)) GRID_BAR(); }
#pragma unroll 1
    for (int l = 0; l < 2; ++l) {
        const int p = 1 + 6 * l;
        const float* ss = (l == 0) ? (const float*)(ws + WS_SS0) : (const float*)(ws + WS_SS1);
        if (IN(p)) {
            pg8::Gemm g{(const pg8::bf16_t*)(ws + (l == 0 ? WS_XN : WS_HB)), (const pg8::bf16_t*)(ws + WS_WIN + l * WIN_BYTES), M, NIN, 1024}; pg8::StaticOrder S; S.init(M, NIN, F.G, (int)blockIdx.x);
            pg8::EpiIn E{ws, ss, IN_ATT_Q_G(args) + l * 64, IN_ATT_K_G(args) + l * 64, 0.125f * 1.4426950408889634f};
            pg8::gemm_phase<pg8::EpiIn, pg8::StaticOrder, true, true>(F.lds + RING_OFF, g, S, E, F.wave);
            gates_phase(F, args, l, ss);
            if (BOTH(p)) GRID_BAR();
        }
        if (IN(p + 1)) { attn_phase(F, args, l); conv_phase(F, args, l); ml_b1(F, args, l); if (BOTH(p + 1)) GRID_BAR(); }
        if (IN(p + 2)) { ml_b2(F); if (BOTH(p + 2)) GRID_BAR(); }
        if (IN(p + 3)) { ml_b3(F, args, l); if (BOTH(p + 3)) GRID_BAR(); }
        if (IN(p + 5)) {
            pg8::Gemm g{(const pg8::bf16_t*)(ws + WS_MIX), (const pg8::bf16_t*)(ws + WS_WOUT + (size_t)l * 2 * MiB), M, DM, 1024}; pg8::StaticOrder S; S.init(M, DM, F.G, (int)blockIdx.x);
            pg8::EpiOut E{(l == 0) ? IN_X(args) : nullptr, (const pg8::bf16_t*)(ws + WS_HB), (l == 0) ? nullptr : args.out, (l == 0) ? (pg8::bf16_t*)(ws + WS_HB) : nullptr, (float*)(ws + WS_SS1)};
            pg8::gemm_phase<pg8::EpiOut, pg8::StaticOrder, true, true>(F.lds + RING_OFF, g, S, E, F.wave);
            if (BOTH(p + 5)) GRID_BAR();
        }
    }
#undef IN
#undef BOTH
}

extern "C" void kernel_launch(void* const* d_in, const int* in_sizes, int n_in, void* d_out, int out_size, void* d_ws, size_t ws_size, hipStream_t stream) {
    static int grid = 0;
    if (grid == 0) {
        if (n_in != 16 || in_sizes[0] != M * DM || out_size != M * DM || ws_size < WS_END) { fprintf(stderr, "kernel_launch: unexpected shapes: n_in %d in0 %d out %d ws %zu\n", n_in, n_in > 0 ? in_sizes[0] : -1, out_size, ws_size); grid = -1; return; }
        int dev = 0, cus = 0;
        if (hipGetDevice(&dev) != hipSuccess || hipDeviceGetAttribute(&cus, hipDeviceAttributeMultiprocessorCount, dev) != hipSuccess) { grid = -1; return; }
        if (hipFuncSetAttribute((const void*)skel_fwd, hipFuncAttributeMaxDynamicSharedMemorySize, LDS_BYTES) != hipSuccess) { fprintf(stderr, "kernel_launch: hipFuncSetAttribute failed\n"); grid = -1; return; }
        int per_cu = 0;
        if (hipOccupancyMaxActiveBlocksPerMultiprocessor(&per_cu, (const void*)skel_fwd, NWAVES * 64, LDS_BYTES) != hipSuccess || per_cu < 1) fprintf(stderr, "kernel_launch: occupancy query reports %d\n", per_cu);
        (void)hipGetLastError();
        grid = cus;
    }
    if (grid < 0) return;
    if (hipMemsetAsync((char*)d_ws + WS_CTL, 0, CTL_ZERO_BYTES, stream) != hipSuccess) return;
    Args a{};
    for (int i = 0; i < 16; ++i) a.in[i] = (const float*)d_in[i];
    a.out = (float*)d_out; a.ws = (unsigned char*)d_ws;
    for (int li = 0; li < N_LAUNCHES; ++li) {
        a.ph_lo = (N_LAUNCHES == 1) ? 0 : li; a.ph_hi = (N_LAUNCHES == 1) ? N_PHASES : li + 1; a.li = li;
        hipLaunchKernelGGL(skel_fwd, dim3(grid), dim3(NWAVES * 64), LDS_BYTES, stream, a);
    }
}
```
